# Optimizing an MI355X kernel written in HIP

```python
import math
import jax, jax.numpy as jnp
from jax import lax
import numpy as np

D_MODEL = 1024
BATCH = 2
SEQ = 8192
DEPTH = 4
DEC_BATCH = 8
DEC_SEQ = 8192
PAST_LEN = 128

N_HEADS = 8
HEAD_DIM = 128
N_KV_HEADS = 2
GROUP = N_HEADS // N_KV_HEADS
WINDOW = 128
BLK = 128
Q_W = N_HEADS * HEAD_DIM
KV_W = N_KV_HEADS * HEAD_DIM
NUM_BUCKETS = 32
MAX_DISTANCE = 128
D_RNN = 1024
RNN_BLOCKS = 8
RNN_BW = D_RNN // RNN_BLOCKS
CONV_W = 4
CONV_LEFT = 2
LRU_C = 8.0
D_FF = 2816
IN_W = Q_W + 2 * KV_W + 2 * D_RNN + 2 * D_MODEL
SPLIT_POINTS = [Q_W, Q_W + KV_W, Q_W + 2 * KV_W, Q_W + 2 * KV_W + D_RNN,
                Q_W + 2 * KV_W + 2 * D_RNN, Q_W + 2 * KV_W + 2 * D_RNN + D_MODEL]
EPS = 1e-6
NEG_INF = -1e30

kernel_name = "hybrid_bidir_local_gqa_rglru_macaron"


def rms_norm(x, g):
    xf = x.astype(jnp.float32)
    y = xf * lax.rsqrt(jnp.mean(xf * xf, axis=-1, keepdims=True) + EPS)
    return (y * g.astype(jnp.float32)).astype(x.dtype)


def swiglu_ffn(x, w_up, w_down):
    gate, up = jnp.split(x @ w_up, 2, axis=-1)
    return (jax.nn.silu(gate) * up) @ w_down


def t5_buckets(rel):
    n = NUM_BUCKETS // 2
    max_exact = n // 2
    ret = (rel > 0).astype(np.int32) * n
    na = np.abs(rel)
    large = max_exact + (np.log(np.maximum(na, 1) / max_exact)
                         / math.log(MAX_DISTANCE / max_exact) * (n - max_exact)).astype(np.int32)
    large = np.minimum(large, n - 1)
    return ret + np.where(na < max_exact, na, large)


def windowed_attention(q, k, v, sink, rel_table):
    B, S = q.shape[0], q.shape[1]
    nb = S // BLK
    qb = q.reshape(B, nb, BLK, N_KV_HEADS, GROUP, HEAD_DIM)

    def band(t):
        tp = jnp.pad(t, ((0, 0), (BLK, BLK), (0, 0), (0, 0))).reshape(B, nb + 2, BLK, N_KV_HEADS, HEAD_DIM)
        return jnp.concatenate([tp[:, :-2], tp[:, 1:-1], tp[:, 2:]], axis=2)

    kb, vb = band(k), band(v)
    scores = jnp.einsum('bnqkgd,bnskd->bnkgqs', qb, kb).astype(jnp.float32) * (HEAD_DIM ** -0.5)

    rel = np.arange(3 * BLK)[None, :] - BLK - np.arange(BLK)[:, None]
    bias = rel_table.astype(jnp.float32)[t5_buckets(rel)]
    bias = jnp.transpose(bias, (2, 0, 1)).reshape(N_KV_HEADS, GROUP, BLK, 3 * BLK)
    jpos = np.arange(nb)[:, None] * BLK - BLK + np.arange(3 * BLK)[None, :]
    mask = (np.abs(rel) <= WINDOW)[None] & ((jpos >= 0) & (jpos < S))[:, None, :]
    mask = mask[None, :, None, None]

    scores = jnp.where(mask, scores + bias, NEG_INF)
    s_h = sink.astype(jnp.float32).reshape(N_KV_HEADS, GROUP, 1, 1)
    m = jnp.maximum(jnp.max(scores, axis=-1, keepdims=True), s_h)
    p = jnp.exp(scores - m)
    probs = p / (jnp.sum(p, axis=-1, keepdims=True) + jnp.exp(s_h - m))
    out = jnp.einsum('bnkgqs,bnskd->bnqkgd', probs.astype(v.dtype), vb)
    return out.reshape(B, S, Q_W)


def depthwise_conv(x, w, b):
    S = x.shape[1]
    xp = jnp.pad(x, ((0, 0), (CONV_LEFT, CONV_W - 1 - CONV_LEFT), (0, 0)))
    y = b
    for tap in range(CONV_W):
        y = y + xp[:, tap:tap + S] * w[tap]
    return y


def linear_scan(a, b):
    def combine(left, right):
        a1, b1 = left
        a2, b2 = right
        return a1 * a2, a2 * b1 + b2
    _, h = lax.associative_scan(combine, (a, b), axis=1)
    return h


def rg_lru_direction(x, lam, w_a, b_a, w_x, b_x, reverse):
    B, S, _ = x.shape
    xb = x.reshape(B, S, RNN_BLOCKS, RNN_BW)
    r = jax.nn.sigmoid(jnp.einsum('bsnc,ncd->bsnd', xb, w_a.astype(jnp.float32)).reshape(B, S, D_RNN)
                       + b_a.astype(jnp.float32))
    i = jax.nn.sigmoid(jnp.einsum('bsnc,ncd->bsnd', xb, w_x.astype(jnp.float32)).reshape(B, S, D_RNN)
                       + b_x.astype(jnp.float32))
    log_a = -LRU_C * r * jax.nn.softplus(-lam.astype(jnp.float32))
    a = jnp.exp(log_a)
    b = jnp.sqrt(-jnp.expm1(2.0 * log_a)) * (i * x)
    if reverse:
        return linear_scan(a[:, ::-1], b[:, ::-1])[:, ::-1]
    return linear_scan(a, b)


def mixer(h, w_in, conv_w, conv_b, lam, w_a, b_a, w_x, b_x, sink, rel_table, w_br_attn, w_br_rnn, w_out):
    B, S, _ = h.shape
    q, k, v, xr, yr, g_attn, g_rnn = jnp.split(h @ w_in, SPLIT_POINTS, axis=-1)
    attn = windowed_attention(q.reshape(B, S, N_HEADS, HEAD_DIM),
                              k.reshape(B, S, N_KV_HEADS, HEAD_DIM),
                              v.reshape(B, S, N_KV_HEADS, HEAD_DIM), sink, rel_table)
    xc = depthwise_conv(xr, conv_w, conv_b).astype(jnp.float32)
    rec = (rg_lru_direction(xc, lam[0], w_a[0], b_a[0], w_x[0], b_x[0], False)
           + rg_lru_direction(xc, lam[1], w_a[1], b_a[1], w_x[1], b_x[1], True))
    rnn = rec.astype(h.dtype) * jax.nn.gelu(yr)
    merged = jax.nn.sigmoid(g_attn) * (attn @ w_br_attn) + jax.nn.sigmoid(g_rnn) * (rnn @ w_br_rnn)
    return merged @ w_out


def trunk(x, ffn1_norm, ffn1_w_up, ffn1_w_down, mix_norm, w_in, conv_w, conv_b, rg_lambda,
          rg_w_a, rg_b_a, rg_w_x, rg_b_x, attn_sink, rel_bias_table, w_br_attn, w_br_rnn, w_out,
          ffn2_norm, ffn2_w_up, ffn2_w_down, final_norm):
    for l in range(DEPTH):
        x = x + 0.5 * swiglu_ffn(rms_norm(x, ffn1_norm[l]), ffn1_w_up[l], ffn1_w_down[l])
        x = x + mixer(rms_norm(x, mix_norm[l]), w_in[l], conv_w[l], conv_b[l], rg_lambda[l],
                      rg_w_a[l], rg_b_a[l], rg_w_x[l], rg_b_x[l], attn_sink[l], rel_bias_table,
                      w_br_attn[l], w_br_rnn[l], w_out[l])
        x = x + 0.5 * swiglu_ffn(rms_norm(x, ffn2_norm[l]), ffn2_w_up[l], ffn2_w_down[l])
    return rms_norm(x, final_norm)


def setup_inputs(seed: int = 0) -> dict:
    key = jax.random.key(seed)
    ks = jax.random.split(key, 26)
    f32 = jnp.float32

    def nrm(k, shape, scale):
        return jax.random.normal(k, shape, f32) * scale

    def gain(k, shape):
        return 1.0 + 0.05 * jax.random.normal(k, shape, f32)

    a0 = jax.random.uniform(ks[7], (DEPTH, 2, D_RNN), f32, 0.9, 0.999)
    return {
        "x_prompt": nrm(ks[0], (BATCH, SEQ, D_MODEL), 1.0),
        "x_sample": nrm(ks[1], (DEC_BATCH, DEC_SEQ, D_MODEL), 1.0),
        "ffn1_norm": gain(ks[2], (DEPTH, D_MODEL)),
        "ffn1_w_up": nrm(ks[3], (DEPTH, D_MODEL, 2 * D_FF), D_MODEL ** -0.5),
        "ffn1_w_down": nrm(ks[4], (DEPTH, D_FF, D_MODEL), D_FF ** -0.5),
        "mix_norm": gain(ks[5], (DEPTH, D_MODEL)),
        "w_in": nrm(ks[6], (DEPTH, D_MODEL, IN_W), D_MODEL ** -0.5),
        "conv_w": nrm(ks[8], (DEPTH, CONV_W, D_RNN), CONV_W ** -0.5),
        "conv_b": nrm(ks[9], (DEPTH, D_RNN), 0.02),
        "rg_lambda": jnp.log(a0) - jnp.log1p(-a0),
        "rg_w_a": nrm(ks[10], (DEPTH, 2, RNN_BLOCKS, RNN_BW, RNN_BW), RNN_BW ** -0.5),
        "rg_b_a": nrm(ks[11], (DEPTH, 2, D_RNN), 0.02),
        "rg_w_x": nrm(ks[12], (DEPTH, 2, RNN_BLOCKS, RNN_BW, RNN_BW), RNN_BW ** -0.5),
        "rg_b_x": nrm(ks[13], (DEPTH, 2, D_RNN), 0.02),
        "attn_sink": nrm(ks[14], (DEPTH, N_HEADS), 0.5),
        "rel_bias_table": nrm(ks[15], (NUM_BUCKETS, N_HEADS), 0.5),
        "w_br_attn": nrm(ks[16], (DEPTH, Q_W, D_MODEL), Q_W ** -0.5),
        "w_br_rnn": nrm(ks[17], (DEPTH, D_RNN, D_MODEL), D_RNN ** -0.5),
        "w_out": nrm(ks[18], (DEPTH, D_MODEL, D_MODEL), D_MODEL ** -0.5),
        "ffn2_norm": gain(ks[19], (DEPTH, D_MODEL)),
        "ffn2_w_up": nrm(ks[20], (DEPTH, D_MODEL, 2 * D_FF), D_MODEL ** -0.5),
        "ffn2_w_down": nrm(ks[21], (DEPTH, D_FF, D_MODEL), D_FF ** -0.5),
        "final_norm": gain(ks[22], (D_MODEL,)),
    }


def reference(x_prompt, x_sample, ffn1_norm, ffn1_w_up, ffn1_w_down, mix_norm, w_in, conv_w, conv_b,
              rg_lambda, rg_w_a, rg_b_a, rg_w_x, rg_b_x, attn_sink, rel_bias_table, w_br_attn,
              w_br_rnn, w_out, ffn2_norm, ffn2_w_up, ffn2_w_down, final_norm):
    y_prompt = trunk(x_prompt, ffn1_norm, ffn1_w_up, ffn1_w_down, mix_norm, w_in, conv_w, conv_b,
                     rg_lambda, rg_w_a, rg_b_a, rg_w_x, rg_b_x, attn_sink, rel_bias_table, w_br_attn,
                     w_br_rnn, w_out, ffn2_norm, ffn2_w_up, ffn2_w_down, final_norm)
    y_sample = trunk(x_sample, ffn1_norm, ffn1_w_up, ffn1_w_down, mix_norm, w_in, conv_w, conv_b,
                     rg_lambda, rg_w_a, rg_b_a, rg_w_x, rg_b_x, attn_sink, rel_bias_table, w_br_attn,
                     w_br_rnn, w_out, ffn2_norm, ffn2_w_up, ffn2_w_down, final_norm)
    return (y_prompt, y_sample)
```

```cpp
#include <hip/hip_runtime.h>
#include <hip/hip_cooperative_groups.h>
#include <cstdio>
#include <cstdint>
namespace cg = cooperative_groups;

#ifndef PER_PHASE_LAUNCH
#define PER_PHASE_LAUNCH 0
#endif

#ifndef PROBE_SKIP
#define PROBE_SKIP 0
#endif
#ifndef EN
#define EN 0xffff
#endif
#define LAS __attribute__((address_space(3)))
typedef unsigned short bf16_t;
typedef short bf16x8 __attribute__((ext_vector_type(8)));
typedef float f32x4 __attribute__((ext_vector_type(4)));
typedef unsigned u32x4 __attribute__((ext_vector_type(4)));
typedef unsigned u32x2 __attribute__((ext_vector_type(2)));

constexpr int D = 1024, DFF = 2816, INW = 5632, SEQ = 8192, DEPTH = 4;
constexpr int T_P = 16384, T_ALL = 81920, T_MAX = 81920, NSEQ = 10, PW = 3584;
constexpr int C_XR = 0, C_Q = 1024, C_K = 2048, C_V = 2304, C_YR = 2560;
constexpr int N_RNN_ITEMS = 160;
constexpr float LOG2E = 1.4426950408889634f;

constexpr size_t OFF_CTL = 0;
constexpr size_t OFF_BIAS = 4096;
constexpr size_t OFF_SSQ = 16384;
constexpr size_t OFF_W = OFF_SSQ + (size_t)T_MAX * 16 * 4;
constexpr size_t W_UP1 = 0;
constexpr size_t W_DN1 = W_UP1 + (size_t)INW * D * 2;
constexpr size_t W_IN = W_DN1 + (size_t)D * DFF * 2;
constexpr size_t W_BRA = W_IN + (size_t)INW * D * 2;
constexpr size_t W_BRR = W_BRA + (size_t)D * D * 2;
constexpr size_t W_OUT = W_BRR + (size_t)D * D * 2;
constexpr size_t W_UP2 = W_OUT + (size_t)D * D * 2;
constexpr size_t W_DN2 = W_UP2 + (size_t)INW * D * 2;
constexpr size_t W_RG = W_DN2 + (size_t)D * DFF * 2;
constexpr size_t W_END = W_RG + (size_t)2 * 8 * 256 * 128 * 2;
constexpr size_t OFF_XB = OFF_W + W_END;
constexpr size_t OFF_PROJ = OFF_XB + (size_t)T_MAX * D * 2;
constexpr size_t OFF_HB = OFF_PROJ + (size_t)T_MAX * PW * 2;
constexpr size_t OFF_BAR = OFF_HB + (size_t)T_MAX * D * 2;
constexpr size_t WS_NEED = OFF_BAR + 16384;
constexpr int LDS_BYTES = 132 * 1024;

enum { K_WCVT = 0, K_UP1, K_DN1, K_PROJA, K_PROJ, K_MIX1, K_MIX2, K_BRA, K_BRR, K_OUT, K_UP2, K_DN2, K_PER_LAYER };
constexpr int NPC = 1 + DEPTH * K_PER_LAYER + 1;
constexpr int NPH = NPC;

__constant__ unsigned char c_bucket[257] = {
15,15,15,15,15,15,15,15,15,15,15,15,15,15,15,15,15,15,15,15,15,15,15,15,15,15,15,15,15,15,15,15,15,15,15,15,15,15,14,14,14,14,14,14,14,14,14,14,14,14,14,14,14,14,14,14,14,14,14,14,14,14,14,14,14,13,13,13,13,13,13,13,13,13,13,13,13,13,13,13,13,13,13,12,12,12,12,12,12,12,12,12,12,12,12,12,12,11,11,11,11,11,11,11,11,11,10,10,10,10,10,10,10,9,9,9,9,8,8,8,8,7,6,5,4,3,2,1,0,17,18,19,20,21,22,23,24,24,24,24,25,25,25,25,26,26,26,26,26,26,26,27,27,27,27,27,27,27,27,27,28,28,28,28,28,28,28,28,28,28,28,28,28,28,29,29,29,29,29,29,29,29,29,29,29,29,29,29,29,29,29,29,30,30,30,30,30,30,30,30,30,30,30,30,30,30,30,30,30,30,30,30,30,30,30,30,30,30,30,31,31,31,31,31,31,31,31,31,31,31,31,31,31,31,31,31,31,31,31,31,31,31,31,31,31,31,31,31,31,31,31,31,31,31,31,31,31};

struct Params { const float* in[23]; float* out; unsigned char* ws; };
typedef const volatile __attribute__((address_space(4))) unsigned long long* kargp_t;
__device__ __forceinline__ unsigned long long KARG(int i) { kargp_t kp = (kargp_t)__builtin_amdgcn_kernarg_segment_ptr(); const unsigned long long v = kp[i];
    const unsigned lo = __builtin_amdgcn_readfirstlane((unsigned)v), hi = __builtin_amdgcn_readfirstlane((unsigned)(v >> 32)); return ((unsigned long long)hi << 32) | lo; }
__device__ __forceinline__ const float* PIN(int i) { return (const float*)KARG(i); }
__device__ __forceinline__ float* POUT() { return (float*)KARG(23); }
__device__ __forceinline__ unsigned char* PWS() { return (unsigned char*)KARG(24); }
__device__ __forceinline__ int TID() { int t = threadIdx.x; asm volatile("" : "+v"(t)); return t; }
__device__ __forceinline__ int BID() { int b = *(const volatile LAS int*)(unsigned)(LDS_BYTES - 24); return __builtin_amdgcn_readfirstlane(b); }
__device__ __forceinline__ unsigned cvt_pk_bf16(float lo, float hi) { unsigned r; asm volatile("v_cvt_pk_bf16_f32 %0, %1, %2" : "=v"(r) : "v"(lo), "v"(hi)); return r; }
__device__ __forceinline__ float bf_lo(unsigned w) { return __uint_as_float(w << 16); }
__device__ __forceinline__ float bf_hi(unsigned w) { return __uint_as_float(w & 0xffff0000u); }
__device__ __forceinline__ float bf_1(bf16_t h) { return __uint_as_float(((unsigned)h) << 16); }
__device__ __forceinline__ float fast_sigmoid(float x) { return __builtin_amdgcn_rcpf(1.0f + __expf(-x)); }
__device__ __forceinline__ float row_rs(const float* ssq, int row) {
    const f32x4* p = (const f32x4*)(ssq + (size_t)row * 16);
    const f32x4 a = p[0], b = p[1], c = p[2], d = p[3];
    const float s = (((a[0] + a[1]) + (a[2] + a[3])) + ((b[0] + b[1]) + (b[2] + b[3]))) + (((c[0] + c[1]) + (c[2] + c[3])) + ((d[0] + d[1]) + (d[2] + d[3])));
    return __builtin_amdgcn_rsqf(s * (1.0f / 1024.0f) + 1e-6f);
}


__device__ __forceinline__ float row_rs4(const float* ssq, int row, int fq) {
    const f32x4 a = *(const f32x4*)(ssq + (size_t)row * 16 + fq * 4);
    float s = (a[0] + a[1]) + (a[2] + a[3]);
    s += __shfl_xor(s, 16); s += __shfl_xor(s, 32);
    return __builtin_amdgcn_rsqf(s * (1.0f / 1024.0f) + 1e-6f);
}

#define XB_TMO      128
#define XB_XCNT(j)  (256  + 64 * (j))
#define XB_XSUB(j)  (1280 + 64 * (j))
#define XB_XGEN(j)  (2304 + 64 * (j))
#define XB_TOP      3328
#define XB_TOPGEN   3392
#define XCD_BAR_WORDS 3456
#define XB_SPIN_CAP (1u << 22)
__device__ __forceinline__ unsigned xb_ld(unsigned* p)              { return __hip_atomic_load(p, __ATOMIC_RELAXED, __HIP_MEMORY_SCOPE_AGENT); }
__device__ __forceinline__ unsigned xb_add(unsigned* p, unsigned v) { return __hip_atomic_fetch_add(p, v, __ATOMIC_RELAXED, __HIP_MEMORY_SCOPE_AGENT); }
__device__ __forceinline__ unsigned xb_xcc_id() { return (unsigned)__builtin_amdgcn_s_getreg((3 << 11) | 20) & 0xFu; }
#define XB_SPIN(cond, bar) do { unsigned _sp = 0; while (cond) { __builtin_amdgcn_s_sleep(1); \
    if ((++_sp & 255u) == 0u) { if (xb_ld(&(bar)[XB_TMO])) break; if (_sp > XB_SPIN_CAP) { atomicAdd(&(bar)[XB_TMO], 1u); break; } } } } while (0)
__device__ __forceinline__ void xcd_barrier_complete(unsigned* bar, unsigned x, unsigned& nloc, unsigned& nx) {
    const unsigned G = gridDim.x;
    unsigned sum, cnt, mine, sp = 0u;
    for (;;) {
        sum = 0u; cnt = 0u; mine = 0u;
#pragma unroll
        for (unsigned j = 0; j < 16; ++j) { const unsigned c = xb_ld(&bar[XB_XCNT(j)]); sum += c; cnt += (c > 0u) ? 1u : 0u; mine = (j == x) ? c : mine; }
        if (sum == G) break;
        __builtin_amdgcn_s_sleep(1);
        if ((++sp & 255u) == 0u) { if (xb_ld(&bar[XB_TMO])) break; if (sp > XB_SPIN_CAP) { atomicAdd(&bar[XB_TMO], 1u); break; } }
    }
    nloc = mine > 0u ? mine : 1u; nx = cnt > 0u ? cnt : 1u;
}
__device__ __forceinline__ void xcd_barrier(unsigned* bar, volatile LAS unsigned* st) {
    asm volatile("s_waitcnt vmcnt(0)" ::: "memory");
    __syncthreads();
    if (TID() == 0) {
        const unsigned x = xb_xcc_id();
        __builtin_amdgcn_s_waitcnt(0);
        unsigned nloc = st[0], nx = st[1];
        if (nloc == 0u) { xcd_barrier_complete(bar, x, nloc, nx); st[0] = nloc; st[1] = nx; }
        const unsigned old = xb_add(&bar[XB_XSUB(x)], 1u);
        const unsigned gen = old / nloc;
        if (old + 1u == (gen + 1u) * nloc) {
            __builtin_amdgcn_fence(__ATOMIC_RELEASE, "agent");
            asm volatile("s_waitcnt vmcnt(0)" ::: "memory");
            const unsigned og = xb_add(&bar[XB_TOP], 1u);
            const unsigned tg = og / nx;
            if (og + 1u == (tg + 1u) * nx) xb_add(&bar[XB_TOPGEN], 1u);
            else XB_SPIN(xb_ld(&bar[XB_TOPGEN]) == tg, bar);
            __builtin_amdgcn_fence(__ATOMIC_ACQUIRE, "agent");
            xb_add(&bar[XB_XGEN(x)], 1u);
            asm volatile("s_waitcnt vmcnt(0)" ::: "memory");
        } else {
            XB_SPIN(xb_ld(&bar[XB_XGEN(x)]) == gen, bar);
            __builtin_amdgcn_fence(__ATOMIC_ACQUIRE, "agent");
            asm volatile("s_waitcnt vmcnt(0)" ::: "memory");
        }
    }
    __syncthreads();
}

__device__ __forceinline__ void sub_arrive_wait(unsigned* cnt, unsigned need, bool arrive) {
    asm volatile("s_waitcnt vmcnt(0)" ::: "memory");
    __syncthreads();
    if (TID() == 0) {
        if (arrive) { __builtin_amdgcn_fence(__ATOMIC_RELEASE, "agent"); asm volatile("s_waitcnt vmcnt(0)" ::: "memory"); (void)xb_add(cnt, 1u); }
        unsigned sp = 0u;
        while (xb_ld(cnt) < need) { __builtin_amdgcn_s_sleep(2); if (++sp > (1u << 24)) break; }
        __builtin_amdgcn_fence(__ATOMIC_ACQUIRE, "agent");
        asm volatile("s_waitcnt vmcnt(0)" ::: "memory");
    }
    __syncthreads();
}

namespace pg8 {
constexpr int BM = 256, BK = 64, HALF = 128, HTB = HALF * BK * 2, STAGE_BYTES = 8 * HTB, NXCD = 8, WGM = 8;
__device__ __forceinline__ int lds_byte(int r, int c) { const int st = (r >> 4) * 2 + (c >> 5), rr = r & 15, cc = c & 31, ob = rr * 64 + cc * 2; return st * 1024 + (ob ^ (((ob >> 9) & 1) << 5)); }
__device__ __forceinline__ void stage_rc(int b, int& R, int& C) { const int st = b / 1024, sb = b % 1024, swz = sb ^ (((sb >> 9) & 1) << 5); R = (st >> 1) * 16 + swz / 64; C = (st & 1) * 32 + (swz % 64) / 2; }
__device__ __forceinline__ int perm32(int rho) { const int n = rho >> 4, i = rho & 15; return 8 * (i >> 2) + 4 * n + (i & 3); }
struct Unit { int pm, pn; };
struct Gemm { const bf16_t* A; const bf16_t* Bt; int lda, ldb, M, N, K; };
struct StaticOrder {
    int nM, nN, nwg, G, c;
    __device__ void init(int M, int N, int G_, int c_) { nM = M / BM; nN = N / BM; nwg = nM * nN; G = G_; c = c_; }
    __device__ bool next(int i, Unit& u) const {
        const long L = (long)i * G + c; if (L >= nwg) return false;
        int wgid = (int)L; { const int q = nwg / NXCD, r = nwg % NXCD, xcd = wgid % NXCD, off = wgid / NXCD; wgid = (xcd < r ? xcd * (q + 1) : r * (q + 1) + (xcd - r) * q) + off; }
        const int nig = WGM * nN, gid = wgid / nig, fm = gid * WGM, gsz = (nM - fm) < WGM ? (nM - fm) : WGM;
        u.pm = fm + ((wgid % nig) % gsz); u.pn = (wgid % nig) / gsz; return true;
    }
};

template <class Epi, bool ALIGN_EPI = true, bool SP2 = true>
__device__ __forceinline__ void gemm_phase(LAS unsigned char* lds, const Gemm g, const Epi& E, int Gw = -1, int cw = 0) {
    const int tid = TID(), wid = __builtin_amdgcn_readfirstlane(tid >> 6), lane = tid & 63, wr = wid >> 2, wc = wid & 3, fr = lane & 15, fq = lane >> 4;
    const int K = g.K, nt = K / BK;
    StaticOrder S; if (Gw < 0) S.init(g.M, g.N, gridDim.x, BID()); else S.init(g.M, g.N, Gw, cw);
    unsigned voffA[2], voffB[2];
#pragma unroll
    for (int i = 0; i < 2; ++i) { int R, C; stage_rc(tid * 16 + i * 8192, R, C); const int Rb = Epi::PERM ? ((R & ~31) + perm32(R & 31)) : R;
        voffA[i] = (unsigned)(R * g.lda + C) * 2u; voffB[i] = (unsigned)(Rb * g.ldb + C) * 2u; }
    const size_t kstep = (size_t)(BK * 2);
    const size_t hstepA = (size_t)HALF * g.lda * 2, hstepB = (size_t)HALF * g.ldb * 2;
    const size_t tstepA = 2 * hstepA, tstepB = 2 * hstepB;
    const unsigned ldsw = (unsigned)wid * 1024u;
    const int aoff = lds_byte(wr * 64 + fr, fq * 8), boff = lds_byte(wc * 32 + fr, fq * 8);
#define PG8_SA(b, h) (((b) * 2 + (h)) * HTB)
#define PG8_SB(b, h) ((4 + (b) * 2 + (h)) * HTB)
#define PG8_STAGE(bufoff, gbase, voff) do { _Pragma("unroll") for (int _i = 0; _i < 2; ++_i) \
        __builtin_amdgcn_global_load_lds((const unsigned*)((const char*)(gbase) + (voff)[_i]), (LAS unsigned*)(lds + (bufoff) + ldsw + _i * 8192), 16, 0, 0); } while (0)
#define PG8_LDA(dst, b, h) do { _Pragma("unroll") for (int m = 0; m < 4; ++m) _Pragma("unroll") for (int k = 0; k < 2; ++k) dst[m][k] = *(const LAS bf16x8*)(lds + PG8_SA(b, h) + aoff + m * 2048 + k * 1024); } while (0)
#define PG8_LDB(dst, b, h) do { _Pragma("unroll") for (int n = 0; n < 2; ++n) _Pragma("unroll") for (int k = 0; k < 2; ++k) dst[n][k] = *(const LAS bf16x8*)(lds + PG8_SB(b, h) + boff + n * 2048 + k * 1024); } while (0)
#define PG8_MMA(ai, bj, At, Bt) do { __builtin_amdgcn_s_setprio(1); _Pragma("unroll") for (int m = 0; m < 4; ++m) _Pragma("unroll") for (int n = 0; n < 2; ++n) _Pragma("unroll") for (int k = 0; k < 2; ++k) \
        acc[ai][bj][m][n] = __builtin_amdgcn_mfma_f32_16x16x32_bf16(Bt[n][k], At[m][k], acc[ai][bj][m][n], 0, 0, 0); __builtin_amdgcn_s_setprio(0); } while (0)
#define PG8_WAIT_V(n) asm volatile("s_waitcnt vmcnt(" #n ")" ::: "memory")
#define PG8_WAIT_L(n) asm volatile("s_waitcnt lgkmcnt(" #n ")" ::: "memory")
#define PG8_BAR __builtin_amdgcn_s_barrier()
#define PG8_SCHED __builtin_amdgcn_sched_barrier(0)
    Unit cur, nxt; int ui = 0;
    if (!S.next(0, cur)) return;
    f32x4 acc[2][2][4][2];
#pragma unroll
    for (int a = 0; a < 2; ++a)
#pragma unroll
        for (int b = 0; b < 2; ++b)
#pragma unroll
            for (int m = 0; m < 4; ++m)
#pragma unroll
                for (int n = 0; n < 2; ++n) acc[a][b][m][n] = (f32x4){0.f, 0.f, 0.f, 0.f};
    bf16x8 At[4][2], B0[2][2], B1[2][2];
    const char* cA = (const char*)g.A + (size_t)cur.pm * tstepA; const char* cB = (const char*)g.Bt + (size_t)cur.pn * tstepB;
    if constexpr (SP2) {
        PG8_STAGE(PG8_SB(0, 0), cB, voffB); PG8_STAGE(PG8_SB(0, 1), cB + hstepB, voffB); PG8_STAGE(PG8_SA(0, 0), cA, voffA); PG8_STAGE(PG8_SA(0, 1), cA + hstepA, voffA);
        if (wr == 1) PG8_BAR;
        PG8_WAIT_V(2); PG8_BAR;
        PG8_STAGE(PG8_SB(1, 0), cB + kstep, voffB); PG8_STAGE(PG8_SA(1, 0), cA + kstep, voffA); PG8_STAGE(PG8_SB(1, 1), cB + hstepB + kstep, voffB);
        PG8_WAIT_V(6); PG8_BAR;
    } else {
    PG8_STAGE(PG8_SB(0, 0), cB, voffB); PG8_STAGE(PG8_SA(0, 0), cA, voffA); PG8_STAGE(PG8_SB(0, 1), cB + hstepB, voffB); PG8_STAGE(PG8_SA(0, 1), cA + hstepA, voffA);
    if (wr == 1) PG8_BAR;
    PG8_WAIT_V(4); PG8_BAR;
    PG8_STAGE(PG8_SB(1, 0), cB + kstep, voffB); PG8_STAGE(PG8_SA(1, 0), cA + kstep, voffA); PG8_STAGE(PG8_SB(1, 1), cB + hstepB + kstep, voffB);
    PG8_WAIT_V(6); PG8_BAR;
    }
    for (;;) {
        const bool has_next = S.next(ui + 1, nxt);
        const char* nA = has_next ? (const char*)g.A + (size_t)nxt.pm * tstepA : cA; const char* nB = has_next ? (const char*)g.Bt + (size_t)nxt.pn * tstepB : cB;
        for (int t = 0; t < nt; t += 2) {
            const bool last = (t == nt - 2);
            const char* a1 = cA + (size_t)(t + 1) * kstep;
            const char* a2 = last ? nA : cA + (size_t)(t + 2) * kstep; const char* b2 = last ? nB : cB + (size_t)(t + 2) * kstep;
            const char* a3 = a2 + kstep; const char* b3 = b2 + kstep;
            if constexpr (SP2) {
            PG8_LDB(B0, 0, 0); PG8_LDB(B1, 0, 1); PG8_SCHED; PG8_LDA(At, 0, 0); PG8_STAGE(PG8_SA(1, 1), a1 + hstepA, voffA);
            PG8_WAIT_V(8); PG8_WAIT_L(0); PG8_BAR; PG8_MMA(0, 0, At, B0); PG8_MMA(0, 1, At, B1); PG8_BAR; PG8_SCHED;
            PG8_LDA(At, 0, 1); PG8_STAGE(PG8_SB(0, 0), b2, voffB); PG8_STAGE(PG8_SB(0, 1), b2 + hstepB, voffB); PG8_STAGE(PG8_SA(0, 0), a2, voffA);
            PG8_WAIT_V(8); PG8_WAIT_L(0); PG8_BAR; PG8_MMA(1, 0, At, B0); PG8_MMA(1, 1, At, B1); PG8_BAR; PG8_SCHED;
            PG8_LDB(B0, 1, 0); PG8_LDB(B1, 1, 1); PG8_SCHED; PG8_LDA(At, 1, 0); PG8_STAGE(PG8_SA(0, 1), a2 + hstepA, voffA);
            PG8_WAIT_V(8); PG8_WAIT_L(0); PG8_BAR; PG8_MMA(0, 0, At, B0); PG8_MMA(0, 1, At, B1); PG8_BAR; PG8_SCHED;
            PG8_LDA(At, 1, 1); PG8_STAGE(PG8_SB(1, 0), b3, voffB); PG8_STAGE(PG8_SB(1, 1), b3 + hstepB, voffB); PG8_STAGE(PG8_SA(1, 0), a3, voffA);
            PG8_WAIT_V(8); PG8_WAIT_L(0); PG8_BAR; PG8_MMA(1, 0, At, B0); PG8_MMA(1, 1, At, B1); PG8_BAR; PG8_SCHED;
            } else {
            PG8_LDB(B0, 0, 0); PG8_SCHED; PG8_LDA(At, 0, 0); PG8_STAGE(PG8_SA(1, 1), a1 + hstepA, voffA);
            PG8_WAIT_L(8); PG8_BAR; PG8_WAIT_L(0); PG8_MMA(0, 0, At, B0); PG8_BAR; PG8_SCHED;
            PG8_LDB(B1, 0, 1); PG8_STAGE(PG8_SB(0, 0), b2, voffB);
            PG8_BAR; PG8_WAIT_L(0); PG8_MMA(0, 1, At, B1); PG8_BAR;
            PG8_LDA(At, 0, 1); PG8_STAGE(PG8_SA(0, 0), a2, voffA);
            PG8_BAR; PG8_WAIT_L(0); PG8_MMA(1, 0, At, B0); PG8_BAR; PG8_SCHED;
            PG8_STAGE(PG8_SB(0, 1), b2 + hstepB, voffB);
            PG8_WAIT_V(6); PG8_BAR; PG8_MMA(1, 1, At, B1); PG8_BAR;
            PG8_LDB(B0, 1, 0); PG8_SCHED; PG8_LDA(At, 1, 0); PG8_STAGE(PG8_SA(0, 1), a2 + hstepA, voffA);
            PG8_WAIT_L(8); PG8_BAR; PG8_WAIT_L(0); PG8_MMA(0, 0, At, B0); PG8_BAR; PG8_SCHED;
            PG8_LDB(B1, 1, 1); PG8_STAGE(PG8_SB(1, 0), b3, voffB);
            PG8_BAR; PG8_WAIT_L(0); PG8_MMA(0, 1, At, B1); PG8_BAR;
            PG8_LDA(At, 1, 1); PG8_STAGE(PG8_SA(1, 0), a3, voffA);
            PG8_BAR; PG8_WAIT_L(0); PG8_MMA(1, 0, At, B0); PG8_BAR; PG8_SCHED;
            PG8_STAGE(PG8_SB(1, 1), b3 + hstepB, voffB);
            PG8_WAIT_V(6); PG8_BAR; PG8_MMA(1, 1, At, B1); PG8_BAR;
            }
        }
        if constexpr (ALIGN_EPI) { if (wr == 0) PG8_BAR; }
        E(acc, cur, wr, wc, fr, fq);
        if (!has_next) break;
#pragma unroll
        for (int a = 0; a < 2; ++a)
#pragma unroll
            for (int b = 0; b < 2; ++b)
#pragma unroll
                for (int m = 0; m < 4; ++m)
#pragma unroll
                    for (int n = 0; n < 2; ++n) acc[a][b][m][n] = (f32x4){0.f, 0.f, 0.f, 0.f};
        cur = nxt; cA = nA; cB = nB; ++ui;
        if constexpr (ALIGN_EPI) { if (wr == 1) PG8_BAR; }
    }
    PG8_WAIT_V(0);
    if constexpr (!ALIGN_EPI) { if (wr == 0) PG8_BAR; }
    PG8_BAR;
#undef PG8_SA
#undef PG8_SB
#undef PG8_STAGE
#undef PG8_LDA
#undef PG8_LDB
#undef PG8_MMA
#undef PG8_WAIT_V
#undef PG8_WAIT_L
#undef PG8_BAR
#undef PG8_SCHED
}

struct EpiSwiGLU {
    static constexpr bool PERM = true;
    const float* ssq; bf16_t* mid;
    __device__ __forceinline__ void operator()(const f32x4 (&acc)[2][2][4][2], const Unit& u, int wr, int wc, int fr, int fq) const {
        const int row0 = u.pm * BM + wr * 64 + fr, col0 = u.pn * 128 + wc * 32 + 8 * fq;
#pragma unroll
        for (int ai = 0; ai < 2; ++ai)
#pragma unroll
            for (int m = 0; m < 4; ++m) {
                const int row = row0 + ai * HALF + m * 16; const float rs = row_rs4(ssq, row, fq), rs2 = rs * rs, nrs = -LOG2E * rs;
                float o[8];
#pragma unroll
                for (int n = 0; n < 2; ++n)
#pragma unroll
                    for (int j = 0; j < 4; ++j) {
                        const float g = acc[ai][0][m][n][j], uu = acc[ai][1][m][n][j];
                        o[n * 4 + j] = (g * uu) * rs2 * __builtin_amdgcn_rcpf(1.0f + __builtin_amdgcn_exp2f(g * nrs)); }
                u32x4 w; w.x = cvt_pk_bf16(o[0], o[1]); w.y = cvt_pk_bf16(o[2], o[3]); w.z = cvt_pk_bf16(o[4], o[5]); w.w = cvt_pk_bf16(o[6], o[7]);
                *(u32x4*)(mid + (size_t)row * DFF + col0) = w;
            }
    }
};
struct EpiResid {
    static constexpr bool PERM = true;
    const float* xin; const float* xin_hi; float* xout; bf16_t* xb; float* ssq; float scale;
    __device__ __forceinline__ void operator()(const f32x4 (&acc)[2][2][4][2], const Unit& u, int wr, int wc, int fr, int fq) const {
        const int row0 = u.pm * BM + wr * 64 + fr, col0 = u.pn * BM + wc * 32 + 8 * fq;
        const float* xin = (u.pm * BM < T_P) ? this->xin : xin_hi;
#pragma unroll
        for (int ai = 0; ai < 2; ++ai)
#pragma unroll
            for (int m = 0; m < 4; ++m) {
                const int row = row0 + ai * HALF + m * 16; const size_t off = (size_t)row * D + col0; float ss = 0.f;
#pragma unroll
                for (int bj = 0; bj < 2; ++bj) {
                    const f32x4 xo0 = *(const f32x4*)(xin + off + bj * HALF), xo1 = *(const f32x4*)(xin + off + bj * HALF + 4);
                    const f32x4 xn0 = xo0 + acc[ai][bj][m][0] * scale, xn1 = xo1 + acc[ai][bj][m][1] * scale;
                    *(f32x4*)(xout + off + bj * HALF) = xn0; *(f32x4*)(xout + off + bj * HALF + 4) = xn1;
                    ss += ((xn0[0] * xn0[0] + xn0[1] * xn0[1]) + (xn0[2] * xn0[2] + xn0[3] * xn0[3])) + ((xn1[0] * xn1[0] + xn1[1] * xn1[1]) + (xn1[2] * xn1[2] + xn1[3] * xn1[3]));
                    u32x4 w; w.x = cvt_pk_bf16(xn0[0], xn0[1]); w.y = cvt_pk_bf16(xn0[2], xn0[3]); w.z = cvt_pk_bf16(xn1[0], xn1[1]); w.w = cvt_pk_bf16(xn1[2], xn1[3]);
                    *(u32x4*)(xb + off + bj * HALF) = w;
                }
                ss += __shfl_xor(ss, 16); ss += __shfl_xor(ss, 32);
                if (fq == 0) ssq[(size_t)row * 16 + u.pn * 4 + wc] = ss;
                if (m == 3) asm volatile("" ::: "memory");
            }
    }
};
struct EpiProj {
    static constexpr bool PERM = true;
    const float* ssq; bf16_t* proj; int pitch;
    __device__ __forceinline__ void operator()(const f32x4 (&acc)[2][2][4][2], const Unit& u, int wr, int wc, int fr, int fq) const {
        const int row0 = u.pm * BM + wr * 64 + fr, col0 = u.pn * BM + wc * 32 + 8 * fq;
#pragma unroll
        for (int ai = 0; ai < 2; ++ai)
#pragma unroll
            for (int m = 0; m < 4; ++m) {
                const int row = row0 + ai * HALF + m * 16; const float rs = row_rs4(ssq, row, fq);
#pragma unroll
                for (int bj = 0; bj < 2; ++bj) {
                    const f32x4 v0 = acc[ai][bj][m][0] * rs, v1 = acc[ai][bj][m][1] * rs;
                    u32x4 w; w.x = cvt_pk_bf16(v0[0], v0[1]); w.y = cvt_pk_bf16(v0[2], v0[3]); w.z = cvt_pk_bf16(v1[0], v1[1]); w.w = cvt_pk_bf16(v1[2], v1[3]);
                    *(u32x4*)(proj + (size_t)row * pitch + col0 + bj * HALF) = w;
                }
            }
    }
};
struct EpiYG {
    static constexpr bool PERM = true;
    const float* ssq; bf16_t* proj; const bf16_t* hb;
    __device__ __forceinline__ void operator()(const f32x4 (&acc)[2][2][4][2], const Unit& u, int wr, int wc, int fr, int fq) const {
        const int row0 = u.pm * BM + wr * 64 + fr, col0 = (u.pn & 3) * BM + wc * 32 + 8 * fq;
        const bool isy = u.pn < 4;
#pragma unroll
        for (int ai = 0; ai < 2; ++ai)
#pragma unroll
            for (int m = 0; m < 4; ++m) {
                const int row = row0 + ai * HALF + m * 16; const float rs = row_rs4(ssq, row, fq);
#pragma unroll
                for (int bj = 0; bj < 2; ++bj) {
                    float o[8];
#pragma unroll
                    for (int n = 0; n < 2; ++n)
#pragma unroll
                        for (int j = 0; j < 4; ++j) o[n * 4 + j] = acc[ai][bj][m][n][j] * rs;
                    bf16_t* dst = proj + (size_t)row * PW + (isy ? C_YR : C_XR) + col0 + bj * HALF;
                    if (isy) {
                        const u32x4 fw = *(const u32x4*)dst; const u32x4 bw = *(const u32x4*)(hb + (size_t)row * D + col0 + bj * HALF);
                        const float hs[8] = {bf_lo(fw.x) + bf_lo(bw.x), bf_hi(fw.x) + bf_hi(bw.x), bf_lo(fw.y) + bf_lo(bw.y), bf_hi(fw.y) + bf_hi(bw.y),
                                             bf_lo(fw.z) + bf_lo(bw.z), bf_hi(fw.z) + bf_hi(bw.z), bf_lo(fw.w) + bf_lo(bw.w), bf_hi(fw.w) + bf_hi(bw.w)};
#pragma unroll
                        for (int i = 0; i < 8; ++i) { const float y = o[i]; o[i] = hs[i] * y * fast_sigmoid(1.5957691216057308f * (y + 0.044715f * y * y * y)); }
                    }
                    u32x4 w; w.x = cvt_pk_bf16(o[0], o[1]); w.y = cvt_pk_bf16(o[2], o[3]); w.z = cvt_pk_bf16(o[4], o[5]); w.w = cvt_pk_bf16(o[6], o[7]);
                    *(u32x4*)dst = w;
                }
            }
    }
};
template <int SECOND> struct EpiBranch {
    static constexpr bool PERM = true;
    bf16_t* proj; bf16_t* hb;
    __device__ __forceinline__ void operator()(const f32x4 (&acc)[2][2][4][2], const Unit& u, int wr, int wc, int fr, int fq) const {
        const int row0 = u.pm * BM + wr * 64 + fr, col0 = u.pn * BM + wc * 32 + 8 * fq;
#pragma unroll
        for (int ai = 0; ai < 2; ++ai)
#pragma unroll
            for (int m = 0; m < 4; ++m) {
                const int row = row0 + ai * HALF + m * 16;
#pragma unroll
                for (int bj = 0; bj < 2; ++bj) {
                    bf16_t* pm1 = proj + (size_t)row * PW + C_XR + col0 + bj * HALF;
                    bf16_t* pg = SECOND ? hb + (size_t)row * D + col0 + bj * HALF : pm1;
                    const u32x4 gw = *(const u32x4*)pg;
                    float gv[8] = {bf_lo(gw.x), bf_hi(gw.x), bf_lo(gw.y), bf_hi(gw.y), bf_lo(gw.z), bf_hi(gw.z), bf_lo(gw.w), bf_hi(gw.w)};
                    float o[8];
#pragma unroll
                    for (int n = 0; n < 2; ++n)
#pragma unroll
                        for (int j = 0; j < 4; ++j) o[n * 4 + j] = fast_sigmoid(gv[n * 4 + j]) * acc[ai][bj][m][n][j];
                    if (SECOND) {
                        const u32x4 mw = *(const u32x4*)pm1;
                        o[0] += bf_lo(mw.x); o[1] += bf_hi(mw.x); o[2] += bf_lo(mw.y); o[3] += bf_hi(mw.y); o[4] += bf_lo(mw.z); o[5] += bf_hi(mw.z); o[6] += bf_lo(mw.w); o[7] += bf_hi(mw.w);
                    }
                    u32x4 w; w.x = cvt_pk_bf16(o[0], o[1]); w.y = cvt_pk_bf16(o[2], o[3]); w.z = cvt_pk_bf16(o[4], o[5]); w.w = cvt_pk_bf16(o[6], o[7]);
                    *(u32x4*)pg = w;
                }
            }
    }
};
}

template <int MAP>
__device__ __forceinline__ void cvt_item(const float* W, int K, int N, bf16_t* Wt, int ldk, const float* gain, LAS float* scr, int item, int lane) {
    const int nblk = N / 32, kb = item / nblk, nb = item % nblk, k0 = 64 * kb, n0 = 32 * nb;
#pragma unroll 8
    for (int i = 0; i < 32; ++i) { const int kk = 2 * i + (lane >> 5); scr[kk * 33 + (lane & 31)] = W[(size_t)(k0 + kk) * N + n0 + (lane & 31)]; }
    asm volatile("s_waitcnt lgkmcnt(0)" ::: "memory");
    const int c = lane & 7;
    float gk[8];
#pragma unroll
    for (int j = 0; j < 8; ++j) gk[j] = gain ? gain[k0 + 8 * c + j] : 1.0f;
#pragma unroll
    for (int j = 0; j < 4; ++j) { const int n = (lane >> 3) + 8 * j; const LAS float* s = scr + (8 * c) * 33 + n;
        u32x4 o; o.x = cvt_pk_bf16(s[0 * 33] * gk[0], s[1 * 33] * gk[1]); o.y = cvt_pk_bf16(s[2 * 33] * gk[2], s[3 * 33] * gk[3]);
        o.z = cvt_pk_bf16(s[4 * 33] * gk[4], s[5 * 33] * gk[5]); o.w = cvt_pk_bf16(s[6 * 33] * gk[6], s[7 * 33] * gk[7]);
        const int ng = n0 + n; int drow = ng;
        if (MAP == 1) { const int half = ng / DFF, r = ng % DFF; drow = (r / 128) * 256 + half * 128 + (r % 128); }
        if (MAP == 2) { drow = ng < 1536 ? ng + 1024 : (ng < 2560 ? ng - 1536 : ng); }
        *(u32x4*)(Wt + (size_t)drow * ldk + k0 + 8 * c) = o; }
    asm volatile("s_waitcnt lgkmcnt(0)" ::: "memory");
}

__device__ __forceinline__ void phase_wcvt(LAS unsigned char* lds, int layer) {
    const int tid = TID(), wave = tid >> 6, lane = tid & 63;
    LAS float* scr = (LAS float*)(lds + wave * 8704);
    unsigned char* wb = PWS() + OFF_W;
    const int gw = BID() * 8 + wave, NGW = gridDim.x * 8;
    constexpr int I_UP = (D / 64) * (INW / 32), I_DN = (DFF / 64) * (D / 32), I_SQ = (D / 64) * (D / 32), I_RG = 32 * 8;
    constexpr int NIT = 3 * I_UP + 2 * I_DN + 3 * I_SQ + I_RG;
    for (int it = gw; it < NIT; it += NGW) {
        int r = it;
        if (r < I_UP) { cvt_item<1>(PIN(3) + (size_t)layer * D * INW, D, INW, (bf16_t*)(wb + W_UP1), D, PIN(2) + layer * D, scr, r, lane); continue; } r -= I_UP;
        if (r < I_UP) { cvt_item<1>(PIN(20) + (size_t)layer * D * INW, D, INW, (bf16_t*)(wb + W_UP2), D, PIN(19) + layer * D, scr, r, lane); continue; } r -= I_UP;
        if (r < I_UP) { cvt_item<2>(PIN(6) + (size_t)layer * D * INW, D, INW, (bf16_t*)(wb + W_IN), D, PIN(5) + layer * D, scr, r, lane); continue; } r -= I_UP;
        if (r < I_DN) { cvt_item<0>(PIN(4) + (size_t)layer * DFF * D, DFF, D, (bf16_t*)(wb + W_DN1), DFF, nullptr, scr, r, lane); continue; } r -= I_DN;
        if (r < I_DN) { cvt_item<0>(PIN(21) + (size_t)layer * DFF * D, DFF, D, (bf16_t*)(wb + W_DN2), DFF, nullptr, scr, r, lane); continue; } r -= I_DN;
        if (r < I_SQ) { cvt_item<0>(PIN(16) + (size_t)layer * D * D, D, D, (bf16_t*)(wb + W_BRA), D, nullptr, scr, r, lane); continue; } r -= I_SQ;
        if (r < I_SQ) { cvt_item<0>(PIN(17) + (size_t)layer * D * D, D, D, (bf16_t*)(wb + W_BRR), D, nullptr, scr, r, lane); continue; } r -= I_SQ;
        if (r < I_SQ) { cvt_item<0>(PIN(18) + (size_t)layer * D * D, D, D, (bf16_t*)(wb + W_OUT), D, nullptr, scr, r, lane); continue; } r -= I_SQ;
        {
            const int mi = r / 8, sub = r % 8, ax = mi & 1, dn = mi >> 1;
            const float* src = (ax ? PIN(12) : PIN(10)) + ((size_t)layer * 16 + dn) * 128 * 128;
            cvt_item<0>(src, 128, 128, (bf16_t*)(wb + W_RG) + ((size_t)dn * 256 + ax * 128) * 128, 128, nullptr, scr, sub, lane);
        }
    }
}

__device__ __forceinline__ void phase_pro(const float* xin_lo, const float* xin_hi, int T) {
    const int tid = TID(), wave = tid >> 6, lane = tid & 63;
    bf16_t* xb = (bf16_t*)(PWS() + OFF_XB); float* ssq = (float*)(PWS() + OFF_SSQ);
    for (int row = BID() * 8 + wave; row < T; row += gridDim.x * 8) {
        const f32x4* xr = (const f32x4*)((row < T_P ? xin_lo : xin_hi) + (size_t)row * D) + lane;
        float s = 0.f; f32x4 v[4];
#pragma unroll
        for (int j = 0; j < 4; ++j) { v[j] = xr[64 * j]; s += (v[j][0] * v[j][0] + v[j][1] * v[j][1]) + (v[j][2] * v[j][2] + v[j][3] * v[j][3]); }
#pragma unroll
        for (int o = 1; o < 64; o <<= 1) s += __shfl_xor(s, o);
        u32x2* o8 = (u32x2*)(xb + (size_t)row * D) + lane;
#pragma unroll
        for (int j = 0; j < 4; ++j) { u32x2 w; w.x = cvt_pk_bf16(v[j][0], v[j][1]); w.y = cvt_pk_bf16(v[j][2], v[j][3]); o8[64 * j] = w; }
        if (lane < 16) ssq[(size_t)row * 16 + lane] = (lane == 0) ? s : 0.f;
    }
    if (BID() == 0) {
        float* bt = (float*)(PWS() + OFF_BIAS);
        for (int i = tid; i < 8 * 257; i += 512) { const int h = i / 257, r = i % 257; bt[i] = PIN(15)[(int)c_bucket[r] * 8 + h] * LOG2E; }
    }
}
__device__ __forceinline__ void phase_fin(float* x, int T) {
    const int tid = TID(), wave = tid >> 6, lane = tid & 63;
    const float* ssq = (const float*)(PWS() + OFF_SSQ); const f32x4* g4 = (const f32x4*)PIN(22) + lane;
    for (int row = BID() * 8 + wave; row < T; row += gridDim.x * 8) {
        const float rs = row_rs(ssq, row);
        f32x4* xr = (f32x4*)(x + (size_t)row * D) + lane;
#pragma unroll
        for (int j = 0; j < 4; ++j) { f32x4 v = xr[64 * j]; v = v * rs * g4[64 * j]; xr[64 * j] = v; }
    }
}

__device__ __forceinline__ void attn_unit(LAS unsigned char* lds, bf16_t* proj, const float* biasG, const float* sink, int s, int qb, int kh, int hp, bf16_t* dummy = nullptr) {
    const int tid = TID(), w = tid >> 6, lane = tid & 63, l16 = lane & 15, kg = lane >> 4;
    const int hl = w >> 2, h = kh * 4 + hp * 2 + hl, wq = w & 3;
    LAS unsigned char* Ks = lds;
    LAS unsigned char* Vt = lds + 34816;
    LAS float* bL = (LAS float*)(lds + 34816 + 36864);
    for (int i = tid; i < 2 * 257; i += 512) { const int a = i / 257, r = i % 257; bL[a * 260 + r] = biasG[(kh * 4 + hp * 2 + a) * 257 + r]; }
    const size_t seqbase = (size_t)s * SEQ;
    const size_t rowbase = seqbase + (size_t)qb * 128 + wq * 32;
    bf16x8 qf[2][4];
#pragma unroll
    for (int qt = 0; qt < 2; ++qt)
#pragma unroll
        for (int ks = 0; ks < 4; ++ks) qf[qt][ks] = *(const bf16x8*)(proj + (rowbase + qt * 16 + l16) * PW + C_Q + h * 128 + ks * 32 + kg * 8);
    float m2[2], lsum[2]; f32x4 o[8][2];
    { const float sk = sink[h] * LOG2E; m2[0] = sk; m2[1] = sk; lsum[0] = (kg == 0) ? 1.f : 0.f; lsum[1] = lsum[0]; }
#pragma unroll
    for (int dt = 0; dt < 8; ++dt) { o[dt][0] = (f32x4){0.f, 0.f, 0.f, 0.f}; o[dt][1] = (f32x4){0.f, 0.f, 0.f, 0.f}; }
    const float SC = 0.08838834764831845f * LOG2E;
    u32x4 kr[4], vr[4];
#define ATT_LOADKV(kb) do { _Pragma("unroll") for (int i_ = 0; i_ < 4; ++i_) { const int c_ = tid + 512 * i_; const int r_ = c_ >> 4, cc_ = c_ & 15; \
        const bf16_t* src_ = proj + (seqbase + (size_t)(kb) * 128 + r_) * PW + kh * 128 + cc_ * 8; kr[i_] = *(const u32x4*)(src_ + C_K); vr[i_] = *(const u32x4*)(src_ + C_V); } } while (0)
#define ATT_STOREKV() do { _Pragma("unroll") for (int i_ = 0; i_ < 4; ++i_) { const int c_ = tid + 512 * i_; const int r_ = c_ >> 4, cc_ = c_ & 15; \
        *(LAS u32x4*)(Ks + r_ * 272 + cc_ * 16) = kr[i_]; LAS unsigned short* vd_ = (LAS unsigned short*)(Vt + (cc_ * 8) * 288 + r_ * 2); const u32x4 vv_ = vr[i_]; \
        vd_[0 * 144] = (unsigned short)(vv_.x & 0xffff); vd_[1 * 144] = (unsigned short)(vv_.x >> 16); vd_[2 * 144] = (unsigned short)(vv_.y & 0xffff); vd_[3 * 144] = (unsigned short)(vv_.y >> 16); \
        vd_[4 * 144] = (unsigned short)(vv_.z & 0xffff); vd_[5 * 144] = (unsigned short)(vv_.z >> 16); vd_[6 * 144] = (unsigned short)(vv_.w & 0xffff); vd_[7 * 144] = (unsigned short)(vv_.w >> 16); } } while (0)
    const int kb_lo = qb > 0 ? 0 : 1, kb_hi = qb < SEQ / 128 - 1 ? 2 : 1;
    ATT_LOADKV(qb - 1 + kb_lo);
    for (int kbi = kb_lo; kbi <= kb_hi; ++kbi) {
        __syncthreads();
        ATT_STOREKV();
        __syncthreads();
        if (kbi < kb_hi) ATT_LOADKV(qb + kbi);
        for (int si = 0; si < 4; ++si) {
            const int st = kbi * 4 + si;
            if (st < wq || st > wq + 8) continue;
            f32x4 sa[2][2];
#pragma unroll
            for (int kt = 0; kt < 2; ++kt) { sa[kt][0] = (f32x4){0.f, 0.f, 0.f, 0.f}; sa[kt][1] = (f32x4){0.f, 0.f, 0.f, 0.f}; }
#pragma unroll
            for (int ks = 0; ks < 4; ++ks)
#pragma unroll
                for (int kt = 0; kt < 2; ++kt) {
                    const bf16x8 kf = *(const LAS bf16x8*)(Ks + (si * 32 + kt * 16 + l16) * 272 + ks * 64 + kg * 16);
                    sa[kt][0] = __builtin_amdgcn_mfma_f32_16x16x32_bf16(kf, qf[0][ks], sa[kt][0], 0, 0, 0);
                    sa[kt][1] = __builtin_amdgcn_mfma_f32_16x16x32_bf16(kf, qf[1][ks], sa[kt][1], 0, 0, 0);
                }
            bf16x8 pf[2];
#pragma unroll
            for (int qt = 0; qt < 2; ++qt) {
                const int qp = wq * 32 + qt * 16 + l16;
                float sv[8]; float mx = -1e30f;
#pragma unroll
                for (int kt = 0; kt < 2; ++kt)
#pragma unroll
                    for (int r = 0; r < 4; ++r) {
                        const int kp = (kbi - 1) * 128 + si * 32 + kt * 16 + kg * 4 + r;
                        const int rel = kp - qp; const bool valid = (rel >= -128) && (rel <= 128);
                        const int idx = min(max(rel + 128, 0), 256);
                        const float v = valid ? (sa[kt][qt][r] * SC + bL[hl * 260 + idx]) : -1e30f;
                        sv[kt * 4 + r] = v; mx = fmaxf(mx, v);
                    }
                mx = fmaxf(mx, __shfl_xor(mx, 16)); mx = fmaxf(mx, __shfl_xor(mx, 32));
                const float mnew = fmaxf(m2[qt], mx), alpha = __builtin_amdgcn_exp2f(m2[qt] - mnew); m2[qt] = mnew;
                float ps = 0.f; float pv[8];
#pragma unroll
                for (int i = 0; i < 8; ++i) { pv[i] = __builtin_amdgcn_exp2f(sv[i] - mnew); ps += pv[i]; }
                lsum[qt] = lsum[qt] * alpha + ps;
#pragma unroll
                for (int dt = 0; dt < 8; ++dt) o[dt][qt] = o[dt][qt] * alpha;
                u32x4 pw; pw.x = cvt_pk_bf16(pv[0], pv[1]); pw.y = cvt_pk_bf16(pv[2], pv[3]); pw.z = cvt_pk_bf16(pv[4], pv[5]); pw.w = cvt_pk_bf16(pv[6], pv[7]);
                pf[qt] = __builtin_bit_cast(bf16x8, pw);
            }
#pragma unroll
            for (int dt = 0; dt < 8; ++dt) {
                const LAS unsigned char* vr = Vt + (dt * 16 + l16) * 288 + (si * 32 + kg * 4) * 2;
                const u32x2 lo = *(const LAS u32x2*)(vr), hi = *(const LAS u32x2*)(vr + 32);
                u32x4 vw; vw.x = lo.x; vw.y = lo.y; vw.z = hi.x; vw.w = hi.y;
                const bf16x8 vf = __builtin_bit_cast(bf16x8, vw);
                o[dt][0] = __builtin_amdgcn_mfma_f32_16x16x32_bf16(vf, pf[0], o[dt][0], 0, 0, 0);
                o[dt][1] = __builtin_amdgcn_mfma_f32_16x16x32_bf16(vf, pf[1], o[dt][1], 0, 0, 0);
            }
        }
    }
#pragma unroll
    for (int qt = 0; qt < 2; ++qt) {
        float lt = lsum[qt]; lt += __shfl_xor(lt, 16); lt += __shfl_xor(lt, 32);
        const float inv = 1.0f / lt;
        bf16_t* orow = dummy ? dummy + (rowbase + qt * 16 + l16) * D + h * 128 + kg * 4 : proj + (rowbase + qt * 16 + l16) * PW + C_Q + h * 128 + kg * 4;
#pragma unroll
        for (int dt = 0; dt < 8; ++dt) { const f32x4 v = o[dt][qt] * inv; u32x2 w; w.x = cvt_pk_bf16(v[0], v[1]); w.y = cvt_pk_bf16(v[2], v[3]); *(u32x2*)(orow + dt * 16) = w; }
    }
}

template <int DIR>
__device__ __forceinline__ void rnn_item(LAS unsigned char* lds, const bf16_t* proj, bf16_t* hout, int hpitch, int layer, int s, int n) {
    const int tid = TID(), w = tid >> 6, lane = tid & 63, l16 = lane & 15, kg = lane >> 4;
    const bf16_t* wg = (const bf16_t*)(PWS() + OFF_W + W_RG) + ((size_t)(DIR * 8 + n) * 256) * 128;
    bf16x8 bfr[2][4];
#pragma unroll
    for (int g2 = 0; g2 < 2; ++g2)
#pragma unroll
        for (int ks = 0; ks < 4; ++ks) bfr[g2][ks] = *(const bf16x8*)(wg + (size_t)(g2 * 128 + w * 16 + l16) * 128 + ks * 32 + kg * 8);
    const int ch = n * 128 + w * 16 + l16;
    const float nba = -LOG2E * PIN(11)[(layer * 2 + DIR) * 1024 + ch], nbx = -LOG2E * PIN(13)[(layer * 2 + DIR) * 1024 + ch];
    const float lamv = PIN(9)[(layer * 2 + DIR) * 1024 + ch];
    const float clam2 = -8.0f * LOG2E * log1pf(expf(-lamv));
    const int cgi = tid & 15, tg = tid >> 4;
    LAS unsigned char* RAW = lds;
    LAS unsigned char* At = lds + 34304;
    LAS float* CW = (LAS float*)(lds + 69120);
    LAS unsigned char* OUTB = lds + 71680;
    if (tid < 128) { const float* cwp = PIN(7); const float* cbp = PIN(8);
#pragma unroll
        for (int t = 0; t < 4; ++t) CW[t * 128 + tid] = cwp[(layer * 4 + t) * 1024 + n * 128 + tid];
        CW[4 * 128 + tid] = cbp[layer * 1024 + n * 128 + tid]; }
    const size_t seqbase = (size_t)s * SEQ;
    const bf16_t* xrbase = proj + seqbase * PW + C_XR + n * 128;
    constexpr int first = DIR == 0 ? 0 : 127, stp = DIR == 0 ? 1 : -1;
    u32x4 R0[3], R1[3], R2[3];
#define RNN_LOADR(dst, sub) do { const int sub_ = (sub); _Pragma("unroll") for (int i_ = 0; i_ < 3; ++i_) { const int c_ = tid + 512 * i_; const int tok_ = sub_ * 64 - 2 + (c_ >> 4); \
        dst[i_] = (c_ < 1072 && sub_ >= 0 && sub_ < 128 && tok_ >= 0 && tok_ < SEQ) ? *(const u32x4*)(xrbase + (size_t)tok_ * PW + (c_ & 15) * 8) : (u32x4){0u, 0u, 0u, 0u}; } } while (0)
#define RNN_PUT(src, slot) do { _Pragma("unroll") for (int i_ = 0; i_ < 3; ++i_) { const int c_ = tid + 512 * i_; if (c_ < 1072) *(LAS u32x4*)(RAW + (slot) * 17152 + c_ * 16) = src[i_]; } } while (0)
#define RNN_CONV(slot, buf) do { float xv_[5][8]; _Pragma("unroll") for (int i_ = 0; i_ < 5; ++i_) { const u32x4 p_ = *(const LAS u32x4*)(RAW + (slot) * 17152 + (2 * tg + i_) * 256 + cgi * 16); \
            xv_[i_][0] = bf_lo(p_.x); xv_[i_][1] = bf_hi(p_.x); xv_[i_][2] = bf_lo(p_.y); xv_[i_][3] = bf_hi(p_.y); xv_[i_][4] = bf_lo(p_.z); xv_[i_][5] = bf_hi(p_.z); xv_[i_][6] = bf_lo(p_.w); xv_[i_][7] = bf_hi(p_.w); } \
        float cw[4][8], cb[8]; _Pragma("unroll") for (int t_ = 0; t_ < 5; ++t_) { const f32x4 c0_ = *(const LAS f32x4*)(CW + t_ * 128 + cgi * 8), c1_ = *(const LAS f32x4*)(CW + t_ * 128 + cgi * 8 + 4); \
            _Pragma("unroll") for (int j_ = 0; j_ < 4; ++j_) { if (t_ < 4) { cw[t_ & 3][j_] = c0_[j_]; cw[t_ & 3][4 + j_] = c1_[j_]; } else { cb[j_] = c0_[j_]; cb[4 + j_] = c1_[j_]; } } } \
        _Pragma("unroll") for (int tt_ = 0; tt_ < 2; ++tt_) { float y_[8]; _Pragma("unroll") for (int j_ = 0; j_ < 8; ++j_) { float a_ = cb[j_]; _Pragma("unroll") for (int t_ = 0; t_ < 4; ++t_) a_ += cw[t_][j_] * xv_[tt_ + t_][j_]; y_[j_] = a_; } \
            const int row_ = 2 * tg + tt_; u32x4 w_; w_.x = cvt_pk_bf16(y_[0], y_[1]); w_.y = cvt_pk_bf16(y_[2], y_[3]); w_.z = cvt_pk_bf16(y_[4], y_[5]); w_.w = cvt_pk_bf16(y_[6], y_[7]); \
            *(LAS u32x4*)(At + (buf) * 17408 + row_ * 272 + cgi * 16) = w_; } } while (0)
#define RNN_BAR() do { asm volatile("s_waitcnt lgkmcnt(0)" ::: "memory"); __builtin_amdgcn_s_barrier(); asm volatile("" ::: "memory"); } while (0)
    RNN_LOADR(R0, first); RNN_LOADR(R1, first + stp); RNN_LOADR(R2, first + 2 * stp);
    RNN_PUT(R0, 0);
    RNN_BAR();
    RNN_CONV(0, 0);
    RNN_PUT(R1, 1);
#pragma unroll
    for (int i = 0; i < 3; ++i) R0[i] = R2[i];
    RNN_LOADR(R1, first + 3 * stp); RNN_LOADR(R2, first + 4 * stp);
    RNN_BAR();
    float hcarry = 0.f;
    for (int it = 0; it < 128; ++it) {
        const int sub = first + it * stp, buf = it & 1;
        RNN_PUT(R0, buf);
#pragma unroll
        for (int i = 0; i < 3; ++i) { R0[i] = R1[i]; R1[i] = R2[i]; }
        RNN_LOADR(R2, sub + 5 * stp);
        RNN_CONV(buf ^ 1, buf ^ 1);
        f32x4 aA[4], aX[4];
#pragma unroll
        for (int mt = 0; mt < 4; ++mt) { aA[mt] = (f32x4){0.f, 0.f, 0.f, 0.f}; aX[mt] = (f32x4){0.f, 0.f, 0.f, 0.f}; }
#pragma unroll
        for (int ks = 0; ks < 4; ++ks)
#pragma unroll
            for (int mt = 0; mt < 4; ++mt) {
                const bf16x8 af = *(const LAS bf16x8*)(At + buf * 17408 + (mt * 16 + l16) * 272 + ks * 64 + kg * 16);
                aA[mt] = __builtin_amdgcn_mfma_f32_16x16x32_bf16(af, bfr[0][ks], aA[mt], 0, 0, 0);
                aX[mt] = __builtin_amdgcn_mfma_f32_16x16x32_bf16(af, bfr[1][ks], aX[mt], 0, 0, 0);
            }
        {   typedef float f32x2 __attribute__((ext_vector_type(2)));
#pragma unroll
            for (int mt = 0; mt < 4; ++mt)
#pragma unroll
                for (int rp = 0; rp < 2; ++rp) {
                    const LAS unsigned char* xp = At + buf * 17408 + (mt * 16 + kg * 4 + 2 * rp) * 272 + (w * 16 + l16) * 2;
                    const f32x2 xc = {bf_1(*(const LAS bf16_t*)xp), bf_1(*(const LAS bf16_t*)(xp + 272))};
                    const f32x2 xa = {aA[mt][2 * rp], aA[mt][2 * rp + 1]}, xx = {aX[mt][2 * rp], aX[mt][2 * rp + 1]};
                    f32x2 ta = xa * (-LOG2E) + nba, tx = xx * (-LOG2E) + nbx;
                    ta.x = fminf(ta.x, 60.f); ta.y = fminf(ta.y, 60.f); tx.x = fminf(tx.x, 60.f); tx.y = fminf(tx.y, 60.f);
                    f32x2 ea, ex; ea.x = __builtin_amdgcn_exp2f(ta.x); ea.y = __builtin_amdgcn_exp2f(ta.y); ex.x = __builtin_amdgcn_exp2f(tx.x); ex.y = __builtin_amdgcn_exp2f(tx.y);
                    const f32x2 da = ea + 1.0f, dx = ex + 1.0f, dd = da * dx;
                    f32x2 inv; inv.x = __builtin_amdgcn_rcpf(dd.x); inv.y = __builtin_amdgcn_rcpf(dd.y);
                    const f32x2 rr = dx * inv, ii = da * inv, tt = rr * clam2;
                    f32x2 av; av.x = __builtin_amdgcn_exp2f(tt.x); av.y = __builtin_amdgcn_exp2f(tt.y);
                    f32x2 om = 1.0f - av * av; om.x = fmaxf(om.x, 0.f); om.y = fmaxf(om.y, 0.f);
                    f32x2 sq; sq.x = __builtin_amdgcn_sqrtf(om.x); sq.y = __builtin_amdgcn_sqrtf(om.y);
                    const f32x2 bv = sq * (ii * xc);
                    aA[mt][2 * rp] = av.x; aA[mt][2 * rp + 1] = av.y; aX[mt][2 * rp] = bv.x; aX[mt][2 * rp + 1] = bv.y;
                }
        }
#pragma unroll
        for (int mt = 0; mt < 4; ++mt) {
            float pp = 1.f, hh = 0.f;
#pragma unroll
            for (int q = 0; q < 4; ++q) { const int r = DIR == 0 ? q : 3 - q; hh = aA[mt][r] * hh + aX[mt][r]; pp *= aA[mt][r]; aA[mt][r] = pp; aX[mt][r] = hh; }
        }
        float start[4]; float carry = hcarry;
#pragma unroll
        for (int hq = 0; hq < 2; ++hq) {
            float Ar[8], Br[8];
#pragma unroll
            for (int q8 = 0; q8 < 8; ++q8) { const int q = hq * 8 + q8; const int rho = DIR == 0 ? q : 15 - q; const int mt = rho >> 2, kgp = rho & 3; constexpr int re = DIR == 0 ? 3 : 0;
                Ar[q8] = __shfl(aA[mt][re], l16 + 16 * kgp); Br[q8] = __shfl(aX[mt][re], l16 + 16 * kgp); }
#pragma unroll
            for (int q8 = 0; q8 < 8; ++q8) { const int q = hq * 8 + q8; const int rho = DIR == 0 ? q : 15 - q; const int mt = rho >> 2, kgp = rho & 3;
                if (kg == kgp) start[mt] = carry;
                carry = Ar[q8] * carry + Br[q8]; }
        }
        hcarry = carry;
        if (it > 0) {
#pragma unroll
            for (int i = 0; i < 2; ++i) { const int c = tid + 512 * i; const u32x4 v = *(const LAS u32x4*)(OUTB + (buf ^ 1) * 16384 + c * 16);
                *(u32x4*)(hout + (seqbase + (size_t)(sub - stp) * 64 + (c >> 4)) * hpitch + n * 128 + (c & 15) * 8) = v; }
        }
        {   LAS unsigned short* ob = (LAS unsigned short*)(OUTB + buf * 16384 + (kg * 4) * 256 + (w * 16 + l16) * 2);
#pragma unroll
            for (int mt = 0; mt < 4; ++mt)
#pragma unroll
                for (int rp = 0; rp < 2; ++rp) {
                    const float h0 = aX[mt][2 * rp] + aA[mt][2 * rp] * start[mt], h1 = aX[mt][2 * rp + 1] + aA[mt][2 * rp + 1] * start[mt];
                    const unsigned pk = cvt_pk_bf16(h0, h1);
                    ob[(mt * 16 + 2 * rp) * 128] = (unsigned short)(pk & 0xffffu); ob[(mt * 16 + 2 * rp + 1) * 128] = (unsigned short)(pk >> 16);
                }
        }
        RNN_BAR();
    }
    {
#pragma unroll
        for (int i = 0; i < 2; ++i) { const int c = tid + 512 * i; const u32x4 v = *(const LAS u32x4*)(OUTB + (127 & 1) * 16384 + c * 16);
            *(u32x4*)(hout + (seqbase + (size_t)(first + 127 * stp) * 64 + (c >> 4)) * hpitch + n * 128 + (c & 15) * 8) = v; }
    }
#undef RNN_LOADR
#undef RNN_PUT
#undef RNN_CONV
#undef RNN_BAR
}

__device__ __forceinline__ void phase_attn(LAS unsigned char* lds, bf16_t* proj, int layer, int nseq, unsigned* ctr) {
    LAS int* slot = (LAS int*)(lds + LDS_BYTES - 16);
    const int total = nseq * 256;
    const float* biasG = (const float*)(PWS() + OFF_BIAS);
    for (;;) {
        __syncthreads();
        if (TID() == 0) *slot = (int)atomicAdd(ctr, 1u);
        __syncthreads();
        const int idx = *slot;
        if (idx >= total) break;
        attn_unit(lds, proj, biasG, PIN(14) + layer * 8, idx >> 8, (idx >> 2) & 63, (idx >> 1) & 1, idx & 1);
    }
}
__device__ __forceinline__ void rnn_by_id(LAS unsigned char* lds, bf16_t* proj, int layer, int wk) {
    bf16_t* hb = (bf16_t*)(PWS() + OFF_HB);
    if (wk & 1) rnn_item<1>(lds, proj, hb, D, layer, wk >> 4, (wk >> 1) & 7); else rnn_item<0>(lds, proj, proj + C_YR, PW, layer, wk >> 4, (wk >> 1) & 7);
}
__global__ void __launch_bounds__(512) mega(Params p, int ph_lo, int ph_hi) {
    extern __shared__ __attribute__((aligned(16))) unsigned char lds_raw[];
    LAS unsigned char* lds = (LAS unsigned char*)lds_raw;
    if (TID() == 0) { volatile LAS unsigned* xst = (volatile LAS unsigned*)(lds + LDS_BYTES - 32); xst[0] = 0u; xst[1] = 0u; const unsigned rank_ = xb_add(&((unsigned*)(PWS() + OFF_BAR))[XB_XCNT(xb_xcc_id())], 1u);
        *(volatile LAS int*)(lds + LDS_BYTES - 24) = (int)blockIdx.x; *(volatile LAS int*)(lds + LDS_BYTES - 20) = (int)rank_; }
    __syncthreads();
#ifdef PROBE_PASS_MASK
    constexpr int NPASS = 2;
#else
    constexpr int NPASS = 1;
#endif
    for (int pass = 0; pass < NPASS; ++pass)
    for (int ph = ph_lo; ph < ph_hi; ++ph) {
#ifdef PROBE_PASS_MASK
        if (pass == 0) { const int q_ = ph; const int bit_ = q_ == 0 ? 0 : (q_ == NPC - 1 ? 1 : 2 + (q_ - 1) % K_PER_LAYER); if (!((PROBE_PASS_MASK >> bit_) & 1)) continue; }
#endif
        unsigned char* const wsb = PWS();
        bf16_t* xb = (bf16_t*)(wsb + OFF_XB); bf16_t* proj = (bf16_t*)(wsb + OFF_PROJ); float* ssq = (float*)(wsb + OFF_SSQ);
        unsigned char* wb = wsb + OFF_W; unsigned* ctl = (unsigned*)(wsb + OFF_CTL) + (NPASS - 1 - pass) * 512;
        const int q = ph;
        constexpr int T = T_ALL;
        float* xo = POUT();
        bf16_t* hb = (bf16_t*)(wsb + OFF_HB);
        if (q == 0) { if (EN & 1) phase_pro(PIN(0), PIN(1) - (size_t)T_P * D, T); }
        else if (q == NPC - 1) { if (EN & 1) phase_fin(xo, T); }
        else {
            const int layer = (q - 1) / K_PER_LAYER, kind = (q - 1) % K_PER_LAYER;
            if (kind == K_WCVT) { if (EN & 2) phase_wcvt(lds, layer); }
            else if (kind == K_UP1 || kind == K_UP2) {
                pg8::Gemm g{xb, (const bf16_t*)(wb + (kind == K_UP1 ? W_UP1 : W_UP2)), D, D, T, INW, D};
                pg8::EpiSwiGLU E{ssq, proj};
                pg8::gemm_phase(lds, g, E);
            } else if (kind == K_DN1 || kind == K_DN2 || kind == K_OUT) {
                pg8::Gemm g; pg8::EpiResid E;
                if (kind == K_OUT) { g = pg8::Gemm{hb, (const bf16_t*)(wb + W_OUT), D, D, T, D, D}; E = pg8::EpiResid{xo, xo, xo, xb, ssq, 1.0f}; }
                else { g = pg8::Gemm{proj, (const bf16_t*)(wb + (kind == K_DN1 ? W_DN1 : W_DN2)), DFF, DFF, T, D, DFF};
                       const bool l0 = (kind == K_DN1 && layer == 0); E = pg8::EpiResid{l0 ? PIN(0) : xo, l0 ? PIN(1) - (size_t)T_P * D : xo, xo, xb, ssq, 0.5f}; }
                pg8::gemm_phase(lds, g, E);
            } else if (kind == K_PROJA) {
                pg8::Gemm g{xb, (const bf16_t*)(wb + W_IN), D, D, T, 1024, D};
                pg8::EpiProj E{ssq, proj + C_XR, PW};
                pg8::gemm_phase(lds, g, E);
            } else if (kind == K_PROJ) {
                pg8::Gemm g{xb, (const bf16_t*)(wb + W_IN) + (size_t)1024 * D, D, D, T, 1536, D};
                pg8::EpiProj E{ssq, proj + 1024, PW};
                const int nb = (int)gridDim.x;
                if (nb >= N_RNN_ITEMS + 64) {
                    unsigned* sub = ctl + 256 + layer * 16;
                    if (BID() < N_RNN_ITEMS) { rnn_by_id(lds, proj, layer, BID()); sub_arrive_wait(sub, (unsigned)(nb - N_RNN_ITEMS), false); }
                    else { pg8::gemm_phase(lds, g, E, nb - N_RNN_ITEMS, BID() - N_RNN_ITEMS); sub_arrive_wait(sub, (unsigned)(nb - N_RNN_ITEMS), true); }
                    phase_attn(lds, proj, layer, NSEQ, ctl + layer * 16);
                } else {
                    pg8::gemm_phase(lds, g, E);
                    for (int wk = BID(); wk < N_RNN_ITEMS; wk += nb) { __syncthreads(); rnn_by_id(lds, proj, layer, wk); }
                }
            } else if (kind == K_MIX1) {
                phase_attn(lds, proj, layer, NSEQ, ctl + layer * 16);
            } else if (kind == K_MIX2) {
                pg8::Gemm g{xb, (const bf16_t*)(wb + W_IN) + (size_t)2560 * D, D, D, T, 2048, D};
                pg8::EpiYG E{ssq, proj, hb};
                pg8::gemm_phase(lds, g, E);
            } else if (kind == K_BRA) {
                { pg8::Gemm g{proj + C_Q, (const bf16_t*)(wb + W_BRA), PW, D, T, D, D};
                  pg8::EpiBranch<0> E{proj, hb};
                  pg8::gemm_phase(lds, g, E); }
                { pg8::Gemm g{xb, (const bf16_t*)(wb + W_IN) + (size_t)4608 * D, D, D, T, 1024, D};
                  pg8::EpiProj E{ssq, hb, D};
                  pg8::gemm_phase(lds, g, E); }
            } else {
                pg8::Gemm g{proj + C_YR, (const bf16_t*)(wb + W_BRR), PW, D, T, D, D};
                pg8::EpiBranch<1> E{proj, hb};
                pg8::gemm_phase(lds, g, E);
            }
        }
        if (ph + 1 < ph_hi || pass + 1 < NPASS) {
#ifdef USE_CG_SYNC
            if (true) cg::this_grid().sync();
#else
            if (ph == ph_lo && pass == 0) {
                cg::this_grid().sync();
                if (TID() == 0) {
                    unsigned* bar = (unsigned*)(PWS() + OFF_BAR); const unsigned per = gridDim.x / 8u; bool ok = (gridDim.x % 8u) == 0u;
#pragma unroll
                    for (unsigned j = 0; j < 16; ++j) { const unsigned c = xb_ld(&bar[XB_XCNT(j)]); ok = ok && (c == (j < 8u ? per : 0u)); }
                    const unsigned x = xb_xcc_id(); const unsigned rank = (unsigned)*(volatile LAS int*)(lds + LDS_BYTES - 20);
                    if (ok && x < 8u && rank < per) *(volatile LAS int*)(lds + LDS_BYTES - 24) = (int)(rank * 8u + x);
                }
                __syncthreads();
            }
#endif
            else xcd_barrier((unsigned*)(PWS() + OFF_BAR), (volatile LAS unsigned*)(lds + LDS_BYTES - 32));
        }
#ifdef PROBE_SYNC3
        if (ph + 1 < ph_hi) { cg::this_grid().sync(); cg::this_grid().sync(); }
#endif
    }
}

extern "C" void kernel_launch(void* const* d_in, const int* in_sizes, int n_in, void* d_out, int out_size, void* d_ws, size_t ws_size, hipStream_t stream) {
    static int grid = 0;
    if (grid == 0) {
        if (n_in != 23 || ws_size < WS_NEED) { fprintf(stderr, "kernel_launch: need 23 inputs and %zu bytes of workspace (got %d, %zu)\n", (size_t)WS_NEED, n_in, ws_size); grid = -1; return; }
        int dev = 0, cus = 0, per_cu = 0;
        hipGetDevice(&dev);
        hipDeviceGetAttribute(&cus, hipDeviceAttributeMultiprocessorCount, dev);
        if (hipFuncSetAttribute((const void*)mega, hipFuncAttributeMaxDynamicSharedMemorySize, LDS_BYTES) != hipSuccess) { fprintf(stderr, "hipFuncSetAttribute failed\n"); grid = -1; return; }
        hipOccupancyMaxActiveBlocksPerMultiprocessor(&per_cu, (const void*)mega, 512, LDS_BYTES);
        if (per_cu < 1) { fprintf(stderr, "occupancy query says %d blocks/CU\n", per_cu); per_cu = 1; }
        (void)hipGetLastError();
        grid = cus * 1;
    }
    if (grid < 0) return;
    hipMemsetAsync((char*)d_ws + OFF_CTL, 0, 4096, stream);
    hipMemsetAsync((char*)d_ws + OFF_BAR, 0, 16384, stream);
    Params p{};
    for (int i = 0; i < 23; ++i) p.in[i] = (const float*)d_in[i];
    p.out = (float*)d_out; p.ws = (unsigned char*)d_ws;
#if PER_PHASE_LAUNCH
    for (int ph = 0; ph < NPH; ++ph) hipLaunchKernelGGL(mega, dim3(grid), dim3(512), LDS_BYTES, stream, p, ph, ph + 1);
#else
    int lo = 0, hi = NPH;
    void* args[] = {&p, &lo, &hi};
    hipError_t e = hipLaunchCooperativeKernel((const void*)mega, dim3(grid), dim3(512), args, LDS_BYTES, stream);
    if (e != hipSuccess) fprintf(stderr, "cooperative launch failed: %s (grid %d)\n", hipGetErrorString(e), grid);
#endif
}
```

```cpp
#include <hip/hip_runtime.h>
#include <hip/hip_cooperative_groups.h>
#include <cstdio>
#include <cstdint>
namespace cg = cooperative_groups;

#ifndef PER_PHASE_LAUNCH
#define PER_PHASE_LAUNCH 0
#endif

#ifndef PROBE_SKIP
#define PROBE_SKIP 0
#endif
#ifndef EN
#define EN 0xffff
#endif
#define LAS __attribute__((address_space(3)))
typedef unsigned short bf16_t;
typedef short bf16x8 __attribute__((ext_vector_type(8)));
typedef float f32x4 __attribute__((ext_vector_type(4)));
typedef unsigned u32x4 __attribute__((ext_vector_type(4)));
typedef unsigned u32x2 __attribute__((ext_vector_type(2)));

constexpr int D = 1024, DFF = 2816, INW = 5632, SEQ = 8192, DEPTH = 4;
constexpr int T_P = 16384, T_ALL = 81920, T_MAX = 81920, NSEQ = 10, PW = 3584;
constexpr int C_XR = 0, C_Q = 1024, C_K = 2048, C_V = 2304, C_YR = 2560;
constexpr int N_RNN_ITEMS = 160;
constexpr float LOG2E = 1.4426950408889634f;

constexpr size_t OFF_CTL = 0;
constexpr size_t OFF_BIAS = 4096;
constexpr size_t OFF_SSQ = 16384;
constexpr size_t OFF_W = OFF_SSQ + (size_t)T_MAX * 16 * 4;
constexpr size_t W_UP1 = 0;
constexpr size_t W_DN1 = W_UP1 + (size_t)INW * D * 2;
constexpr size_t W_IN = W_DN1 + (size_t)D * DFF * 2;
constexpr size_t W_BRA = W_IN + (size_t)INW * D * 2;
constexpr size_t W_BRR = W_BRA + (size_t)D * D * 2;
constexpr size_t W_OUT = W_BRR + (size_t)D * D * 2;
constexpr size_t W_UP2 = W_OUT + (size_t)D * D * 2;
constexpr size_t W_DN2 = W_UP2 + (size_t)INW * D * 2;
constexpr size_t W_RG = W_DN2 + (size_t)D * DFF * 2;
constexpr size_t W_END = W_RG + (size_t)2 * 8 * 256 * 128 * 2;
constexpr size_t OFF_XB = OFF_W + W_END;
constexpr size_t OFF_PROJ = OFF_XB + (size_t)T_MAX * D * 2;
constexpr size_t OFF_HB = OFF_PROJ + (size_t)T_MAX * PW * 2;
constexpr size_t OFF_BAR = OFF_HB + (size_t)T_MAX * D * 2;
constexpr size_t WS_NEED = OFF_BAR + 16384;
constexpr int LDS_BYTES = 132 * 1024;

enum { K_WCVT = 0, K_UP1, K_DN1, K_PROJA, K_PROJ, K_MIX1, K_MIX2, K_BRA, K_BRR, K_OUT, K_UP2, K_DN2, K_PER_LAYER };
constexpr int NPC = 1 + DEPTH * K_PER_LAYER + 1;
constexpr int NPH = NPC;

__constant__ unsigned char c_bucket[257] = {
15,15,15,15,15,15,15,15,15,15,15,15,15,15,15,15,15,15,15,15,15,15,15,15,15,15,15,15,15,15,15,15,15,15,15,15,15,15,14,14,14,14,14,14,14,14,14,14,14,14,14,14,14,14,14,14,14,14,14,14,14,14,14,14,14,13,13,13,13,13,13,13,13,13,13,13,13,13,13,13,13,13,13,12,12,12,12,12,12,12,12,12,12,12,12,12,12,11,11,11,11,11,11,11,11,11,10,10,10,10,10,10,10,9,9,9,9,8,8,8,8,7,6,5,4,3,2,1,0,17,18,19,20,21,22,23,24,24,24,24,25,25,25,25,26,26,26,26,26,26,26,27,27,27,27,27,27,27,27,27,28,28,28,28,28,28,28,28,28,28,28,28,28,28,29,29,29,29,29,29,29,29,29,29,29,29,29,29,29,29,29,29,30,30,30,30,30,30,30,30,30,30,30,30,30,30,30,30,30,30,30,30,30,30,30,30,30,30,30,31,31,31,31,31,31,31,31,31,31,31,31,31,31,31,31,31,31,31,31,31,31,31,31,31,31,31,31,31,31,31,31,31,31,31,31,31,31};

struct Params { const float* in[23]; float* out; unsigned char* ws; };
typedef const volatile __attribute__((address_space(4))) unsigned long long* kargp_t;
__device__ __forceinline__ unsigned long long KARG(int i) { kargp_t kp = (kargp_t)__builtin_amdgcn_kernarg_segment_ptr(); const unsigned long long v = kp[i];
    const unsigned lo = __builtin_amdgcn_readfirstlane((unsigned)v), hi = __builtin_amdgcn_readfirstlane((unsigned)(v >> 32)); return ((unsigned long long)hi << 32) | lo; }
__device__ __forceinline__ const float* PIN(int i) { return (const float*)KARG(i); }
__device__ __forceinline__ float* POUT() { return (float*)KARG(23); }
__device__ __forceinline__ unsigned char* PWS() { return (unsigned char*)KARG(24); }
__device__ __forceinline__ int TID() { int t = threadIdx.x; asm volatile("" : "+v"(t)); return t; }
__device__ __forceinline__ int BID() { int b = blockIdx.x; asm volatile("" : "+s"(b)); return b; }
__device__ __forceinline__ unsigned cvt_pk_bf16(float lo, float hi) { unsigned r; asm volatile("v_cvt_pk_bf16_f32 %0, %1, %2" : "=v"(r) : "v"(lo), "v"(hi)); return r; }
__device__ __forceinline__ float bf_lo(unsigned w) { return __uint_as_float(w << 16); }
__device__ __forceinline__ float bf_hi(unsigned w) { return __uint_as_float(w & 0xffff0000u); }
__device__ __forceinline__ float bf_1(bf16_t h) { return __uint_as_float(((unsigned)h) << 16); }
__device__ __forceinline__ float fast_sigmoid(float x) { return __builtin_amdgcn_rcpf(1.0f + __expf(-x)); }
__device__ __forceinline__ float row_rs(const float* ssq, int row) {
    const f32x4* p = (const f32x4*)(ssq + (size_t)row * 16);
    const f32x4 a = p[0], b = p[1], c = p[2], d = p[3];
    const float s = (((a[0] + a[1]) + (a[2] + a[3])) + ((b[0] + b[1]) + (b[2] + b[3]))) + (((c[0] + c[1]) + (c[2] + c[3])) + ((d[0] + d[1]) + (d[2] + d[3])));
    return __builtin_amdgcn_rsqf(s * (1.0f / 1024.0f) + 1e-6f);
}


__device__ __forceinline__ float row_rs4(const float* ssq, int row, int fq) {
    const f32x4 a = *(const f32x4*)(ssq + (size_t)row * 16 + fq * 4);
    float s = (a[0] + a[1]) + (a[2] + a[3]);
    s += __shfl_xor(s, 16); s += __shfl_xor(s, 32);
    return __builtin_amdgcn_rsqf(s * (1.0f / 1024.0f) + 1e-6f);
}

#define XB_TMO      128
#define XB_XCNT(j)  (256  + 64 * (j))
#define XB_XSUB(j)  (1280 + 64 * (j))
#define XB_XGEN(j)  (2304 + 64 * (j))
#define XB_TOP      3328
#define XB_TOPGEN   3392
#define XCD_BAR_WORDS 3456
#define XB_SPIN_CAP (1u << 22)
__device__ __forceinline__ unsigned xb_ld(unsigned* p)              { return __hip_atomic_load(p, __ATOMIC_RELAXED, __HIP_MEMORY_SCOPE_AGENT); }
__device__ __forceinline__ unsigned xb_add(unsigned* p, unsigned v) { return __hip_atomic_fetch_add(p, v, __ATOMIC_RELAXED, __HIP_MEMORY_SCOPE_AGENT); }
__device__ __forceinline__ unsigned xb_xcc_id() { return (unsigned)__builtin_amdgcn_s_getreg((3 << 11) | 20) & 0xFu; }
#define XB_SPIN(cond, bar) do { unsigned _sp = 0; while (cond) { __builtin_amdgcn_s_sleep(1); \
    if ((++_sp & 255u) == 0u) { if (xb_ld(&(bar)[XB_TMO])) break; if (_sp > XB_SPIN_CAP) { atomicAdd(&(bar)[XB_TMO], 1u); break; } } } } while (0)
__device__ __forceinline__ void xcd_barrier_complete(unsigned* bar, unsigned x, unsigned& nloc, unsigned& nx) {
    const unsigned G = gridDim.x;
    unsigned sum, cnt, mine, sp = 0u;
    for (;;) {
        sum = 0u; cnt = 0u; mine = 0u;
#pragma unroll
        for (unsigned j = 0; j < 16; ++j) { const unsigned c = xb_ld(&bar[XB_XCNT(j)]); sum += c; cnt += (c > 0u) ? 1u : 0u; mine = (j == x) ? c : mine; }
        if (sum == G) break;
        __builtin_amdgcn_s_sleep(1);
        if ((++sp & 255u) == 0u) { if (xb_ld(&bar[XB_TMO])) break; if (sp > XB_SPIN_CAP) { atomicAdd(&bar[XB_TMO], 1u); break; } }
    }
    nloc = mine > 0u ? mine : 1u; nx = cnt > 0u ? cnt : 1u;
}
__device__ __forceinline__ void xcd_barrier(unsigned* bar, volatile LAS unsigned* st) {
    asm volatile("s_waitcnt vmcnt(0)" ::: "memory");
    __syncthreads();
    if (TID() == 0) {
        const unsigned x = xb_xcc_id();
        __builtin_amdgcn_s_waitcnt(0);
        unsigned nloc = st[0], nx = st[1];
        if (nloc == 0u) { xcd_barrier_complete(bar, x, nloc, nx); st[0] = nloc; st[1] = nx; }
        const unsigned old = xb_add(&bar[XB_XSUB(x)], 1u);
        const unsigned gen = old / nloc;
        if (old + 1u == (gen + 1u) * nloc) {
            __builtin_amdgcn_fence(__ATOMIC_RELEASE, "agent");
            asm volatile("s_waitcnt vmcnt(0)" ::: "memory");
            const unsigned og = xb_add(&bar[XB_TOP], 1u);
            const unsigned tg = og / nx;
            if (og + 1u == (tg + 1u) * nx) xb_add(&bar[XB_TOPGEN], 1u);
            else XB_SPIN(xb_ld(&bar[XB_TOPGEN]) == tg, bar);
            __builtin_amdgcn_fence(__ATOMIC_ACQUIRE, "agent");
            xb_add(&bar[XB_XGEN(x)], 1u);
            asm volatile("s_waitcnt vmcnt(0)" ::: "memory");
        } else {
            XB_SPIN(xb_ld(&bar[XB_XGEN(x)]) == gen, bar);
            __builtin_amdgcn_fence(__ATOMIC_ACQUIRE, "agent");
            asm volatile("s_waitcnt vmcnt(0)" ::: "memory");
        }
    }
    __syncthreads();
}

__device__ __forceinline__ void sub_arrive_wait(unsigned* cnt, unsigned need, bool arrive) {
    asm volatile("s_waitcnt vmcnt(0)" ::: "memory");
    __syncthreads();
    if (TID() == 0) {
        if (arrive) { __builtin_amdgcn_fence(__ATOMIC_RELEASE, "agent"); asm volatile("s_waitcnt vmcnt(0)" ::: "memory"); (void)xb_add(cnt, 1u); }
        unsigned sp = 0u;
        while (xb_ld(cnt) < need) { __builtin_amdgcn_s_sleep(2); if (++sp > (1u << 24)) break; }
        __builtin_amdgcn_fence(__ATOMIC_ACQUIRE, "agent");
        asm volatile("s_waitcnt vmcnt(0)" ::: "memory");
    }
    __syncthreads();
}

namespace pg8 {
constexpr int BM = 256, BK = 64, HALF = 128, HTB = HALF * BK * 2, STAGE_BYTES = 8 * HTB, NXCD = 8, WGM = 8;
__device__ __forceinline__ int lds_byte(int r, int c) { const int st = (r >> 4) * 2 + (c >> 5), rr = r & 15, cc = c & 31, ob = rr * 64 + cc * 2; return st * 1024 + (ob ^ (((ob >> 9) & 1) << 5)); }
__device__ __forceinline__ void stage_rc(int b, int& R, int& C) { const int st = b / 1024, sb = b % 1024, swz = sb ^ (((sb >> 9) & 1) << 5); R = (st >> 1) * 16 + swz / 64; C = (st & 1) * 32 + (swz % 64) / 2; }
__device__ __forceinline__ int perm32(int rho) { const int n = rho >> 4, i = rho & 15; return 8 * (i >> 2) + 4 * n + (i & 3); }
struct Unit { int pm, pn; };
struct Gemm { const bf16_t* A; const bf16_t* Bt; int lda, ldb, M, N, K; };
struct StaticOrder {
    int nM, nN, nwg, G, c;
    __device__ void init(int M, int N, int G_, int c_) { nM = M / BM; nN = N / BM; nwg = nM * nN; G = G_; c = c_; }
    __device__ bool next(int i, Unit& u) const {
        const long L = (long)i * G + c; if (L >= nwg) return false;
        int wgid = (int)L; { const int q = nwg / NXCD, r = nwg % NXCD, xcd = wgid % NXCD, off = wgid / NXCD; wgid = (xcd < r ? xcd * (q + 1) : r * (q + 1) + (xcd - r) * q) + off; }
        const int nig = WGM * nN, gid = wgid / nig, fm = gid * WGM, gsz = (nM - fm) < WGM ? (nM - fm) : WGM;
        u.pm = fm + ((wgid % nig) % gsz); u.pn = (wgid % nig) / gsz; return true;
    }
};

template <class Epi, bool ALIGN_EPI = true, bool SP2 = true>
__device__ __forceinline__ void gemm_phase(LAS unsigned char* lds, const Gemm g, const Epi& E, int Gw = -1, int cw = 0) {
    const int tid = TID(), wid = __builtin_amdgcn_readfirstlane(tid >> 6), lane = tid & 63, wr = wid >> 2, wc = wid & 3, fr = lane & 15, fq = lane >> 4;
    const int K = g.K, nt = K / BK;
    StaticOrder S; if (Gw < 0) S.init(g.M, g.N, gridDim.x, BID()); else S.init(g.M, g.N, Gw, cw);
    unsigned voffA[2], voffB[2];
#pragma unroll
    for (int i = 0; i < 2; ++i) { int R, C; stage_rc(tid * 16 + i * 8192, R, C);
        const int Rb = Epi::WIDE ? (64 * (R >> 5) + perm32(R & 31)) : (Epi::PERM ? ((R & ~31) + perm32(R & 31)) : R);
        voffA[i] = (unsigned)(R * g.lda + C) * 2u; voffB[i] = (unsigned)(Rb * g.ldb + C) * 2u; }
    const size_t kstep = (size_t)(BK * 2);
    const size_t hstepA = (size_t)HALF * g.lda * 2, hstepB = (size_t)(Epi::WIDE ? 32 : HALF) * g.ldb * 2;
    const size_t tstepA = 2 * hstepA, tstepB = (size_t)BM * g.ldb * 2;
    const unsigned ldsw = (unsigned)wid * 1024u;
    const int aoff = lds_byte(wr * 64 + fr, fq * 8), boff = lds_byte(wc * 32 + fr, fq * 8);
#define PG8_SA(b, h) (((b) * 2 + (h)) * HTB)
#define PG8_SB(b, h) ((4 + (b) * 2 + (h)) * HTB)
#define PG8_STAGE(bufoff, gbase, voff) do { _Pragma("unroll") for (int _i = 0; _i < 2; ++_i) \
        __builtin_amdgcn_global_load_lds((const unsigned*)((const char*)(gbase) + (voff)[_i]), (LAS unsigned*)(lds + (bufoff) + ldsw + _i * 8192), 16, 0, 0); } while (0)
#define PG8_LDA(dst, b, h) do { _Pragma("unroll") for (int m = 0; m < 4; ++m) _Pragma("unroll") for (int k = 0; k < 2; ++k) dst[m][k] = *(const LAS bf16x8*)(lds + PG8_SA(b, h) + aoff + m * 2048 + k * 1024); } while (0)
#define PG8_LDB(dst, b, h) do { _Pragma("unroll") for (int n = 0; n < 2; ++n) _Pragma("unroll") for (int k = 0; k < 2; ++k) dst[n][k] = *(const LAS bf16x8*)(lds + PG8_SB(b, h) + boff + n * 2048 + k * 1024); } while (0)
#define PG8_MMA(ai, bj, At, Bt) do { __builtin_amdgcn_s_setprio(1); _Pragma("unroll") for (int m = 0; m < 4; ++m) _Pragma("unroll") for (int n = 0; n < 2; ++n) _Pragma("unroll") for (int k = 0; k < 2; ++k) \
        acc[ai][bj][m][n] = __builtin_amdgcn_mfma_f32_16x16x32_bf16(Bt[n][k], At[m][k], acc[ai][bj][m][n], 0, 0, 0); __builtin_amdgcn_s_setprio(0); } while (0)
#define PG8_WAIT_V(n) asm volatile("s_waitcnt vmcnt(" #n ")" ::: "memory")
#define PG8_WAIT_L(n) asm volatile("s_waitcnt lgkmcnt(" #n ")" ::: "memory")
#define PG8_BAR __builtin_amdgcn_s_barrier()
#define PG8_SCHED __builtin_amdgcn_sched_barrier(0)
    Unit cur, nxt; int ui = 0;
    if (!S.next(0, cur)) return;
    f32x4 acc[2][2][4][2];
#pragma unroll
    for (int a = 0; a < 2; ++a)
#pragma unroll
        for (int b = 0; b < 2; ++b)
#pragma unroll
            for (int m = 0; m < 4; ++m)
#pragma unroll
                for (int n = 0; n < 2; ++n) acc[a][b][m][n] = (f32x4){0.f, 0.f, 0.f, 0.f};
    bf16x8 At[4][2], B0[2][2], B1[2][2];
    const char* cA = (const char*)g.A + (size_t)cur.pm * tstepA; const char* cB = (const char*)g.Bt + (size_t)cur.pn * tstepB;
    if constexpr (SP2) {
        PG8_STAGE(PG8_SB(0, 0), cB, voffB); PG8_STAGE(PG8_SB(0, 1), cB + hstepB, voffB); PG8_STAGE(PG8_SA(0, 0), cA, voffA); PG8_STAGE(PG8_SA(0, 1), cA + hstepA, voffA);
        if (wr == 1) PG8_BAR;
        PG8_WAIT_V(2); PG8_BAR;
        PG8_STAGE(PG8_SB(1, 0), cB + kstep, voffB); PG8_STAGE(PG8_SA(1, 0), cA + kstep, voffA); PG8_STAGE(PG8_SB(1, 1), cB + hstepB + kstep, voffB);
        PG8_WAIT_V(6); PG8_BAR;
    } else {
    PG8_STAGE(PG8_SB(0, 0), cB, voffB); PG8_STAGE(PG8_SA(0, 0), cA, voffA); PG8_STAGE(PG8_SB(0, 1), cB + hstepB, voffB); PG8_STAGE(PG8_SA(0, 1), cA + hstepA, voffA);
    if (wr == 1) PG8_BAR;
    PG8_WAIT_V(4); PG8_BAR;
    PG8_STAGE(PG8_SB(1, 0), cB + kstep, voffB); PG8_STAGE(PG8_SA(1, 0), cA + kstep, voffA); PG8_STAGE(PG8_SB(1, 1), cB + hstepB + kstep, voffB);
    PG8_WAIT_V(6); PG8_BAR;
    }
    for (;;) {
        const bool has_next = S.next(ui + 1, nxt);
        const char* nA = has_next ? (const char*)g.A + (size_t)nxt.pm * tstepA : cA; const char* nB = has_next ? (const char*)g.Bt + (size_t)nxt.pn * tstepB : cB;
        for (int t = 0; t < nt; t += 2) {
            const bool last = (t == nt - 2);
            const char* a1 = cA + (size_t)(t + 1) * kstep;
            const char* a2 = last ? nA : cA + (size_t)(t + 2) * kstep; const char* b2 = last ? nB : cB + (size_t)(t + 2) * kstep;
            const char* a3 = a2 + kstep; const char* b3 = b2 + kstep;
            if constexpr (SP2) {
            PG8_LDB(B0, 0, 0); PG8_LDB(B1, 0, 1); PG8_SCHED; PG8_LDA(At, 0, 0); PG8_STAGE(PG8_SA(1, 1), a1 + hstepA, voffA);
            PG8_WAIT_V(8); PG8_WAIT_L(0); PG8_BAR; PG8_MMA(0, 0, At, B0); PG8_MMA(0, 1, At, B1); PG8_BAR; PG8_SCHED;
            PG8_LDA(At, 0, 1); PG8_STAGE(PG8_SB(0, 0), b2, voffB); PG8_STAGE(PG8_SB(0, 1), b2 + hstepB, voffB); PG8_STAGE(PG8_SA(0, 0), a2, voffA);
            PG8_WAIT_V(8); PG8_WAIT_L(0); PG8_BAR; PG8_MMA(1, 0, At, B0); PG8_MMA(1, 1, At, B1); PG8_BAR; PG8_SCHED;
            PG8_LDB(B0, 1, 0); PG8_LDB(B1, 1, 1); PG8_SCHED; PG8_LDA(At, 1, 0); PG8_STAGE(PG8_SA(0, 1), a2 + hstepA, voffA);
            PG8_WAIT_V(8); PG8_WAIT_L(0); PG8_BAR; PG8_MMA(0, 0, At, B0); PG8_MMA(0, 1, At, B1); PG8_BAR; PG8_SCHED;
            PG8_LDA(At, 1, 1); PG8_STAGE(PG8_SB(1, 0), b3, voffB); PG8_STAGE(PG8_SB(1, 1), b3 + hstepB, voffB); PG8_STAGE(PG8_SA(1, 0), a3, voffA);
            PG8_WAIT_V(8); PG8_WAIT_L(0); PG8_BAR; PG8_MMA(1, 0, At, B0); PG8_MMA(1, 1, At, B1); PG8_BAR; PG8_SCHED;
            } else {
            PG8_LDB(B0, 0, 0); PG8_SCHED; PG8_LDA(At, 0, 0); PG8_STAGE(PG8_SA(1, 1), a1 + hstepA, voffA);
            PG8_WAIT_L(8); PG8_BAR; PG8_WAIT_L(0); PG8_MMA(0, 0, At, B0); PG8_BAR; PG8_SCHED;
            PG8_LDB(B1, 0, 1); PG8_STAGE(PG8_SB(0, 0), b2, voffB);
            PG8_BAR; PG8_WAIT_L(0); PG8_MMA(0, 1, At, B1); PG8_BAR;
            PG8_LDA(At, 0, 1); PG8_STAGE(PG8_SA(0, 0), a2, voffA);
            PG8_BAR; PG8_WAIT_L(0); PG8_MMA(1, 0, At, B0); PG8_BAR; PG8_SCHED;
            PG8_STAGE(PG8_SB(0, 1), b2 + hstepB, voffB);
            PG8_WAIT_V(6); PG8_BAR; PG8_MMA(1, 1, At, B1); PG8_BAR;
            PG8_LDB(B0, 1, 0); PG8_SCHED; PG8_LDA(At, 1, 0); PG8_STAGE(PG8_SA(0, 1), a2 + hstepA, voffA);
            PG8_WAIT_L(8); PG8_BAR; PG8_WAIT_L(0); PG8_MMA(0, 0, At, B0); PG8_BAR; PG8_SCHED;
            PG8_LDB(B1, 1, 1); PG8_STAGE(PG8_SB(1, 0), b3, voffB);
            PG8_BAR; PG8_WAIT_L(0); PG8_MMA(0, 1, At, B1); PG8_BAR;
            PG8_LDA(At, 1, 1); PG8_STAGE(PG8_SA(1, 0), a3, voffA);
            PG8_BAR; PG8_WAIT_L(0); PG8_MMA(1, 0, At, B0); PG8_BAR; PG8_SCHED;
            PG8_STAGE(PG8_SB(1, 1), b3 + hstepB, voffB);
            PG8_WAIT_V(6); PG8_BAR; PG8_MMA(1, 1, At, B1); PG8_BAR;
            }
        }
        if constexpr (ALIGN_EPI) { if (wr == 0) PG8_BAR; }
        E(acc, cur, wr, wc, fr, fq);
        if (!has_next) break;
#pragma unroll
        for (int a = 0; a < 2; ++a)
#pragma unroll
            for (int b = 0; b < 2; ++b)
#pragma unroll
                for (int m = 0; m < 4; ++m)
#pragma unroll
                    for (int n = 0; n < 2; ++n) acc[a][b][m][n] = (f32x4){0.f, 0.f, 0.f, 0.f};
        cur = nxt; cA = nA; cB = nB; ++ui;
        if constexpr (ALIGN_EPI) { if (wr == 1) PG8_BAR; }
    }
    PG8_WAIT_V(0);
    if constexpr (!ALIGN_EPI) { if (wr == 0) PG8_BAR; }
    PG8_BAR;
#undef PG8_SA
#undef PG8_SB
#undef PG8_STAGE
#undef PG8_LDA
#undef PG8_LDB
#undef PG8_MMA
#undef PG8_WAIT_V
#undef PG8_WAIT_L
#undef PG8_BAR
#undef PG8_SCHED
}

struct EpiSwiGLU {
    static constexpr bool PERM = true, WIDE = false;
    const float* ssq; bf16_t* mid;
    __device__ __forceinline__ void operator()(const f32x4 (&acc)[2][2][4][2], const Unit& u, int wr, int wc, int fr, int fq) const {
        const int row0 = u.pm * BM + wr * 64 + fr, col0 = u.pn * 128 + wc * 32 + 8 * fq;
#pragma unroll
        for (int ai = 0; ai < 2; ++ai)
#pragma unroll
            for (int m = 0; m < 4; ++m) {
                const int row = row0 + ai * HALF + m * 16; const float rs = row_rs4(ssq, row, fq), rs2 = rs * rs, nrs = -LOG2E * rs;
                float o[8];
#pragma unroll
                for (int n = 0; n < 2; ++n)
#pragma unroll
                    for (int j = 0; j < 4; ++j) {
                        const float g = acc[ai][0][m][n][j], uu = acc[ai][1][m][n][j];
                        o[n * 4 + j] = (g * uu) * rs2 * __builtin_amdgcn_rcpf(1.0f + __builtin_amdgcn_exp2f(g * nrs)); }
                u32x4 w; w.x = cvt_pk_bf16(o[0], o[1]); w.y = cvt_pk_bf16(o[2], o[3]); w.z = cvt_pk_bf16(o[4], o[5]); w.w = cvt_pk_bf16(o[6], o[7]);
                *(u32x4*)(mid + (size_t)row * DFF + col0) = w;
            }
    }
};
struct EpiResid {
    static constexpr bool PERM = true, WIDE = false;
    const float* xin; const float* xin_hi; float* xout; bf16_t* xb; float* ssq; float scale;
    __device__ __forceinline__ void operator()(const f32x4 (&acc)[2][2][4][2], const Unit& u, int wr, int wc, int fr, int fq) const {
        const int row0 = u.pm * BM + wr * 64 + fr, col0 = u.pn * BM + wc * 32 + 8 * fq;
        const float* xin = (u.pm * BM < T_P) ? this->xin : xin_hi;
#pragma unroll
        for (int ai = 0; ai < 2; ++ai)
#pragma unroll
            for (int m = 0; m < 4; ++m) {
                const int row = row0 + ai * HALF + m * 16; const size_t off = (size_t)row * D + col0; float ss = 0.f;
#pragma unroll
                for (int bj = 0; bj < 2; ++bj) {
                    const f32x4 xo0 = *(const f32x4*)(xin + off + bj * HALF), xo1 = *(const f32x4*)(xin + off + bj * HALF + 4);
                    const f32x4 xn0 = xo0 + acc[ai][bj][m][0] * scale, xn1 = xo1 + acc[ai][bj][m][1] * scale;
                    *(f32x4*)(xout + off + bj * HALF) = xn0; *(f32x4*)(xout + off + bj * HALF + 4) = xn1;
                    ss += ((xn0[0] * xn0[0] + xn0[1] * xn0[1]) + (xn0[2] * xn0[2] + xn0[3] * xn0[3])) + ((xn1[0] * xn1[0] + xn1[1] * xn1[1]) + (xn1[2] * xn1[2] + xn1[3] * xn1[3]));
                    u32x4 w; w.x = cvt_pk_bf16(xn0[0], xn0[1]); w.y = cvt_pk_bf16(xn0[2], xn0[3]); w.z = cvt_pk_bf16(xn1[0], xn1[1]); w.w = cvt_pk_bf16(xn1[2], xn1[3]);
                    *(u32x4*)(xb + off + bj * HALF) = w;
                }
                ss += __shfl_xor(ss, 16); ss += __shfl_xor(ss, 32);
                if (fq == 0) ssq[(size_t)row * 16 + u.pn * 4 + wc] = ss;
                if (m == 3) asm volatile("" ::: "memory");
            }
    }
};
struct EpiProj {
    static constexpr bool PERM = true, WIDE = true;
    const float* ssq; bf16_t* proj; int pitch;
    __device__ __forceinline__ void operator()(const f32x4 (&acc)[2][2][4][2], const Unit& u, int wr, int wc, int fr, int fq) const {
        const int row0 = u.pm * BM + wr * 64 + fr, col0 = u.pn * BM + wc * 64 + 8 * fq;
#pragma unroll
        for (int ai = 0; ai < 2; ++ai)
#pragma unroll
            for (int m = 0; m < 4; ++m) {
                const int row = row0 + ai * HALF + m * 16; const float rs = row_rs4(ssq, row, fq);
#pragma unroll
                for (int bj = 0; bj < 2; ++bj) {
                    const f32x4 v0 = acc[ai][bj][m][0] * rs, v1 = acc[ai][bj][m][1] * rs;
                    u32x4 w; w.x = cvt_pk_bf16(v0[0], v0[1]); w.y = cvt_pk_bf16(v0[2], v0[3]); w.z = cvt_pk_bf16(v1[0], v1[1]); w.w = cvt_pk_bf16(v1[2], v1[3]);
                    *(u32x4*)(proj + (size_t)row * pitch + col0 + bj * 32) = w;
                }
            }
    }
};
struct EpiYG {
    static constexpr bool PERM = true, WIDE = true;
    const float* ssq; bf16_t* proj; const bf16_t* hb;
    __device__ __forceinline__ void operator()(const f32x4 (&acc)[2][2][4][2], const Unit& u, int wr, int wc, int fr, int fq) const {
        const int row0 = u.pm * BM + wr * 64 + fr, col0 = (u.pn & 3) * BM + wc * 64 + 8 * fq;
        const bool isy = u.pn < 4;
#pragma unroll
        for (int ai = 0; ai < 2; ++ai)
#pragma unroll
            for (int m = 0; m < 4; ++m) {
                const int row = row0 + ai * HALF + m * 16; const float rs = row_rs4(ssq, row, fq);
#pragma unroll
                for (int bj = 0; bj < 2; ++bj) {
                    float o[8];
#pragma unroll
                    for (int n = 0; n < 2; ++n)
#pragma unroll
                        for (int j = 0; j < 4; ++j) o[n * 4 + j] = acc[ai][bj][m][n][j] * rs;
                    bf16_t* dst = proj + (size_t)row * PW + (isy ? C_YR : C_XR) + col0 + bj * 32;
                    if (isy) {
                        const u32x4 fw = *(const u32x4*)dst; const u32x4 bw = *(const u32x4*)(hb + (size_t)row * D + col0 + bj * 32);
                        const float hs[8] = {bf_lo(fw.x) + bf_lo(bw.x), bf_hi(fw.x) + bf_hi(bw.x), bf_lo(fw.y) + bf_lo(bw.y), bf_hi(fw.y) + bf_hi(bw.y),
                                             bf_lo(fw.z) + bf_lo(bw.z), bf_hi(fw.z) + bf_hi(bw.z), bf_lo(fw.w) + bf_lo(bw.w), bf_hi(fw.w) + bf_hi(bw.w)};
#pragma unroll
                        for (int i = 0; i < 8; ++i) { const float y = o[i]; o[i] = hs[i] * y * fast_sigmoid(1.5957691216057308f * (y + 0.044715f * y * y * y)); }
                    }
                    u32x4 w; w.x = cvt_pk_bf16(o[0], o[1]); w.y = cvt_pk_bf16(o[2], o[3]); w.z = cvt_pk_bf16(o[4], o[5]); w.w = cvt_pk_bf16(o[6], o[7]);
                    *(u32x4*)dst = w;
                }
            }
    }
};
template <int SECOND> struct EpiBranch {
    static constexpr bool PERM = true, WIDE = true;
    bf16_t* proj; bf16_t* hb;
    __device__ __forceinline__ void operator()(const f32x4 (&acc)[2][2][4][2], const Unit& u, int wr, int wc, int fr, int fq) const {
        const int row0 = u.pm * BM + wr * 64 + fr, col0 = u.pn * BM + wc * 64 + 8 * fq;
#pragma unroll
        for (int ai = 0; ai < 2; ++ai)
#pragma unroll
            for (int m = 0; m < 4; ++m) {
                const int row = row0 + ai * HALF + m * 16;
#pragma unroll
                for (int bj = 0; bj < 2; ++bj) {
                    bf16_t* pm1 = proj + (size_t)row * PW + C_XR + col0 + bj * 32;
                    bf16_t* pg = SECOND ? hb + (size_t)row * D + col0 + bj * 32 : pm1;
                    const u32x4 gw = *(const u32x4*)pg;
                    float gv[8] = {bf_lo(gw.x), bf_hi(gw.x), bf_lo(gw.y), bf_hi(gw.y), bf_lo(gw.z), bf_hi(gw.z), bf_lo(gw.w), bf_hi(gw.w)};
                    float o[8];
#pragma unroll
                    for (int n = 0; n < 2; ++n)
#pragma unroll
                        for (int j = 0; j < 4; ++j) o[n * 4 + j] = fast_sigmoid(gv[n * 4 + j]) * acc[ai][bj][m][n][j];
                    if (SECOND) {
                        const u32x4 mw = *(const u32x4*)pm1;
                        o[0] += bf_lo(mw.x); o[1] += bf_hi(mw.x); o[2] += bf_lo(mw.y); o[3] += bf_hi(mw.y); o[4] += bf_lo(mw.z); o[5] += bf_hi(mw.z); o[6] += bf_lo(mw.w); o[7] += bf_hi(mw.w);
                    }
                    u32x4 w; w.x = cvt_pk_bf16(o[0], o[1]); w.y = cvt_pk_bf16(o[2], o[3]); w.z = cvt_pk_bf16(o[4], o[5]); w.w = cvt_pk_bf16(o[6], o[7]);
                    *(u32x4*)pg = w;
                }
            }
    }
};
}

template <int MAP>
__device__ __forceinline__ void cvt_item(const float* W, int K, int N, bf16_t* Wt, int ldk, const float* gain, LAS float* scr, int item, int lane) {
    const int nblk = N / 32, kb = item / nblk, nb = item % nblk, k0 = 64 * kb, n0 = 32 * nb;
#pragma unroll 8
    for (int i = 0; i < 32; ++i) { const int kk = 2 * i + (lane >> 5); scr[kk * 33 + (lane & 31)] = W[(size_t)(k0 + kk) * N + n0 + (lane & 31)]; }
    asm volatile("s_waitcnt lgkmcnt(0)" ::: "memory");
    const int c = lane & 7;
    float gk[8];
#pragma unroll
    for (int j = 0; j < 8; ++j) gk[j] = gain ? gain[k0 + 8 * c + j] : 1.0f;
#pragma unroll
    for (int j = 0; j < 4; ++j) { const int n = (lane >> 3) + 8 * j; const LAS float* s = scr + (8 * c) * 33 + n;
        u32x4 o; o.x = cvt_pk_bf16(s[0 * 33] * gk[0], s[1 * 33] * gk[1]); o.y = cvt_pk_bf16(s[2 * 33] * gk[2], s[3 * 33] * gk[3]);
        o.z = cvt_pk_bf16(s[4 * 33] * gk[4], s[5 * 33] * gk[5]); o.w = cvt_pk_bf16(s[6 * 33] * gk[6], s[7 * 33] * gk[7]);
        const int ng = n0 + n; int drow = ng;
        if (MAP == 1) { const int half = ng / DFF, r = ng % DFF; drow = (r / 128) * 256 + half * 128 + (r % 128); }
        if (MAP == 2) { drow = ng < 1536 ? ng + 1024 : (ng < 2560 ? ng - 1536 : ng); }
        *(u32x4*)(Wt + (size_t)drow * ldk + k0 + 8 * c) = o; }
    asm volatile("s_waitcnt lgkmcnt(0)" ::: "memory");
}

__device__ __forceinline__ void phase_wcvt(LAS unsigned char* lds, int layer) {
    const int tid = TID(), wave = tid >> 6, lane = tid & 63;
    LAS float* scr = (LAS float*)(lds + wave * 8704);
    unsigned char* wb = PWS() + OFF_W;
    const int gw = BID() * 8 + wave, NGW = gridDim.x * 8;
    constexpr int I_UP = (D / 64) * (INW / 32), I_DN = (DFF / 64) * (D / 32), I_SQ = (D / 64) * (D / 32), I_RG = 32 * 8;
    constexpr int NIT = 3 * I_UP + 2 * I_DN + 3 * I_SQ + I_RG;
    for (int it = gw; it < NIT; it += NGW) {
        int r = it;
        if (r < I_UP) { cvt_item<1>(PIN(3) + (size_t)layer * D * INW, D, INW, (bf16_t*)(wb + W_UP1), D, PIN(2) + layer * D, scr, r, lane); continue; } r -= I_UP;
        if (r < I_UP) { cvt_item<1>(PIN(20) + (size_t)layer * D * INW, D, INW, (bf16_t*)(wb + W_UP2), D, PIN(19) + layer * D, scr, r, lane); continue; } r -= I_UP;
        if (r < I_UP) { cvt_item<2>(PIN(6) + (size_t)layer * D * INW, D, INW, (bf16_t*)(wb + W_IN), D, PIN(5) + layer * D, scr, r, lane); continue; } r -= I_UP;
        if (r < I_DN) { cvt_item<0>(PIN(4) + (size_t)layer * DFF * D, DFF, D, (bf16_t*)(wb + W_DN1), DFF, nullptr, scr, r, lane); continue; } r -= I_DN;
        if (r < I_DN) { cvt_item<0>(PIN(21) + (size_t)layer * DFF * D, DFF, D, (bf16_t*)(wb + W_DN2), DFF, nullptr, scr, r, lane); continue; } r -= I_DN;
        if (r < I_SQ) { cvt_item<0>(PIN(16) + (size_t)layer * D * D, D, D, (bf16_t*)(wb + W_BRA), D, nullptr, scr, r, lane); continue; } r -= I_SQ;
        if (r < I_SQ) { cvt_item<0>(PIN(17) + (size_t)layer * D * D, D, D, (bf16_t*)(wb + W_BRR), D, nullptr, scr, r, lane); continue; } r -= I_SQ;
        if (r < I_SQ) { cvt_item<0>(PIN(18) + (size_t)layer * D * D, D, D, (bf16_t*)(wb + W_OUT), D, nullptr, scr, r, lane); continue; } r -= I_SQ;
        {
            const int mi = r / 8, sub = r % 8, ax = mi & 1, dn = mi >> 1;
            const float* src = (ax ? PIN(12) : PIN(10)) + ((size_t)layer * 16 + dn) * 128 * 128;
            cvt_item<0>(src, 128, 128, (bf16_t*)(wb + W_RG) + ((size_t)dn * 256 + ax * 128) * 128, 128, nullptr, scr, sub, lane);
        }
    }
}

__device__ __forceinline__ void phase_pro(const float* xin_lo, const float* xin_hi, int T) {
    const int tid = TID(), wave = tid >> 6, lane = tid & 63;
    bf16_t* xb = (bf16_t*)(PWS() + OFF_XB); float* ssq = (float*)(PWS() + OFF_SSQ);
    for (int row = BID() * 8 + wave; row < T; row += gridDim.x * 8) {
        const f32x4* xr = (const f32x4*)((row < T_P ? xin_lo : xin_hi) + (size_t)row * D) + lane;
        float s = 0.f; f32x4 v[4];
#pragma unroll
        for (int j = 0; j < 4; ++j) { v[j] = xr[64 * j]; s += (v[j][0] * v[j][0] + v[j][1] * v[j][1]) + (v[j][2] * v[j][2] + v[j][3] * v[j][3]); }
#pragma unroll
        for (int o = 1; o < 64; o <<= 1) s += __shfl_xor(s, o);
        u32x2* o8 = (u32x2*)(xb + (size_t)row * D) + lane;
#pragma unroll
        for (int j = 0; j < 4; ++j) { u32x2 w; w.x = cvt_pk_bf16(v[j][0], v[j][1]); w.y = cvt_pk_bf16(v[j][2], v[j][3]); o8[64 * j] = w; }
        if (lane < 16) ssq[(size_t)row * 16 + lane] = (lane == 0) ? s : 0.f;
    }
    if (BID() == 0) {
        float* bt = (float*)(PWS() + OFF_BIAS);
        for (int i = tid; i < 8 * 257; i += 512) { const int h = i / 257, r = i % 257; bt[i] = PIN(15)[(int)c_bucket[r] * 8 + h] * LOG2E; }
    }
}
__device__ __forceinline__ void phase_fin(float* x, int T) {
    const int tid = TID(), wave = tid >> 6, lane = tid & 63;
    const float* ssq = (const float*)(PWS() + OFF_SSQ); const f32x4* g4 = (const f32x4*)PIN(22) + lane;
    for (int row = BID() * 8 + wave; row < T; row += gridDim.x * 8) {
        const float rs = row_rs(ssq, row);
        f32x4* xr = (f32x4*)(x + (size_t)row * D) + lane;
#pragma unroll
        for (int j = 0; j < 4; ++j) { f32x4 v = xr[64 * j]; v = v * rs * g4[64 * j]; xr[64 * j] = v; }
    }
}

__device__ __forceinline__ void attn_unit(LAS unsigned char* lds, bf16_t* proj, const float* biasG, const float* sink, int s, int qb, int kh, int hp, bf16_t* dummy = nullptr) {
    const int tid = TID(), w = tid >> 6, lane = tid & 63, l16 = lane & 15, kg = lane >> 4;
    const int hl = w >> 2, h = kh * 4 + hp * 2 + hl, wq = w & 3;
    LAS unsigned char* Ks = lds;
    LAS unsigned char* Vt = lds + 34816;
    LAS float* bL = (LAS float*)(lds + 34816 + 36864);
    for (int i = tid; i < 2 * 257; i += 512) { const int a = i / 257, r = i % 257; bL[a * 260 + r] = biasG[(kh * 4 + hp * 2 + a) * 257 + r]; }
    const size_t seqbase = (size_t)s * SEQ;
    const size_t rowbase = seqbase + (size_t)qb * 128 + wq * 32;
    bf16x8 qf[2][4];
#pragma unroll
    for (int qt = 0; qt < 2; ++qt)
#pragma unroll
        for (int ks = 0; ks < 4; ++ks) qf[qt][ks] = *(const bf16x8*)(proj + (rowbase + qt * 16 + l16) * PW + C_Q + h * 128 + ks * 32 + kg * 8);
    float m2[2], lsum[2]; f32x4 o[8][2];
    { const float sk = sink[h] * LOG2E; m2[0] = sk; m2[1] = sk; lsum[0] = (kg == 0) ? 1.f : 0.f; lsum[1] = lsum[0]; }
#pragma unroll
    for (int dt = 0; dt < 8; ++dt) { o[dt][0] = (f32x4){0.f, 0.f, 0.f, 0.f}; o[dt][1] = (f32x4){0.f, 0.f, 0.f, 0.f}; }
    const float SC = 0.08838834764831845f * LOG2E;
    u32x4 kr[4], vr[4];
#define ATT_LOADKV(kb) do { _Pragma("unroll") for (int i_ = 0; i_ < 4; ++i_) { const int c_ = tid + 512 * i_; const int r_ = c_ >> 4, cc_ = c_ & 15; \
        const bf16_t* src_ = proj + (seqbase + (size_t)(kb) * 128 + r_) * PW + kh * 128 + cc_ * 8; kr[i_] = *(const u32x4*)(src_ + C_K); vr[i_] = *(const u32x4*)(src_ + C_V); } } while (0)
#define ATT_STOREKV() do { _Pragma("unroll") for (int i_ = 0; i_ < 4; ++i_) { const int c_ = tid + 512 * i_; const int r_ = c_ >> 4, cc_ = c_ & 15; \
        *(LAS u32x4*)(Ks + r_ * 272 + cc_ * 16) = kr[i_]; LAS unsigned short* vd_ = (LAS unsigned short*)(Vt + (cc_ * 8) * 288 + r_ * 2); const u32x4 vv_ = vr[i_]; \
        vd_[0 * 144] = (unsigned short)(vv_.x & 0xffff); vd_[1 * 144] = (unsigned short)(vv_.x >> 16); vd_[2 * 144] = (unsigned short)(vv_.y & 0xffff); vd_[3 * 144] = (unsigned short)(vv_.y >> 16); \
        vd_[4 * 144] = (unsigned short)(vv_.z & 0xffff); vd_[5 * 144] = (unsigned short)(vv_.z >> 16); vd_[6 * 144] = (unsigned short)(vv_.w & 0xffff); vd_[7 * 144] = (unsigned short)(vv_.w >> 16); } } while (0)
    const int kb_lo = qb > 0 ? 0 : 1, kb_hi = qb < SEQ / 128 - 1 ? 2 : 1;
    ATT_LOADKV(qb - 1 + kb_lo);
    for (int kbi = kb_lo; kbi <= kb_hi; ++kbi) {
        __syncthreads();
        ATT_STOREKV();
        __syncthreads();
        if (kbi < kb_hi) ATT_LOADKV(qb + kbi);
        for (int si = 0; si < 4; ++si) {
            const int st = kbi * 4 + si;
            if (st < wq || st > wq + 8) continue;
            f32x4 sa[2][2];
#pragma unroll
            for (int kt = 0; kt < 2; ++kt) { sa[kt][0] = (f32x4){0.f, 0.f, 0.f, 0.f}; sa[kt][1] = (f32x4){0.f, 0.f, 0.f, 0.f}; }
#pragma unroll
            for (int ks = 0; ks < 4; ++ks)
#pragma unroll
                for (int kt = 0; kt < 2; ++kt) {
                    const bf16x8 kf = *(const LAS bf16x8*)(Ks + (si * 32 + kt * 16 + l16) * 272 + ks * 64 + kg * 16);
                    sa[kt][0] = __builtin_amdgcn_mfma_f32_16x16x32_bf16(kf, qf[0][ks], sa[kt][0], 0, 0, 0);
                    sa[kt][1] = __builtin_amdgcn_mfma_f32_16x16x32_bf16(kf, qf[1][ks], sa[kt][1], 0, 0, 0);
                }
            bf16x8 pf[2];
#pragma unroll
            for (int qt = 0; qt < 2; ++qt) {
                const int qp = wq * 32 + qt * 16 + l16;
                float sv[8]; float mx = -1e30f;
#pragma unroll
                for (int kt = 0; kt < 2; ++kt)
#pragma unroll
                    for (int r = 0; r < 4; ++r) {
                        const int kp = (kbi - 1) * 128 + si * 32 + kt * 16 + kg * 4 + r;
                        const int rel = kp - qp; const bool valid = (rel >= -128) && (rel <= 128);
                        const int idx = min(max(rel + 128, 0), 256);
                        const float v = valid ? (sa[kt][qt][r] * SC + bL[hl * 260 + idx]) : -1e30f;
                        sv[kt * 4 + r] = v; mx = fmaxf(mx, v);
                    }
                mx = fmaxf(mx, __shfl_xor(mx, 16)); mx = fmaxf(mx, __shfl_xor(mx, 32));
                const float mnew = fmaxf(m2[qt], mx), alpha = __builtin_amdgcn_exp2f(m2[qt] - mnew); m2[qt] = mnew;
                float ps = 0.f; float pv[8];
#pragma unroll
                for (int i = 0; i < 8; ++i) { pv[i] = __builtin_amdgcn_exp2f(sv[i] - mnew); ps += pv[i]; }
                lsum[qt] = lsum[qt] * alpha + ps;
#pragma unroll
                for (int dt = 0; dt < 8; ++dt) o[dt][qt] = o[dt][qt] * alpha;
                u32x4 pw; pw.x = cvt_pk_bf16(pv[0], pv[1]); pw.y = cvt_pk_bf16(pv[2], pv[3]); pw.z = cvt_pk_bf16(pv[4], pv[5]); pw.w = cvt_pk_bf16(pv[6], pv[7]);
                pf[qt] = __builtin_bit_cast(bf16x8, pw);
            }
#pragma unroll
            for (int dt = 0; dt < 8; ++dt) {
                const LAS unsigned char* vr = Vt + (dt * 16 + l16) * 288 + (si * 32 + kg * 4) * 2;
                const u32x2 lo = *(const LAS u32x2*)(vr), hi = *(const LAS u32x2*)(vr + 32);
                u32x4 vw; vw.x = lo.x; vw.y = lo.y; vw.z = hi.x; vw.w = hi.y;
                const bf16x8 vf = __builtin_bit_cast(bf16x8, vw);
                o[dt][0] = __builtin_amdgcn_mfma_f32_16x16x32_bf16(vf, pf[0], o[dt][0], 0, 0, 0);
                o[dt][1] = __builtin_amdgcn_mfma_f32_16x16x32_bf16(vf, pf[1], o[dt][1], 0, 0, 0);
            }
        }
    }
#pragma unroll
    for (int qt = 0; qt < 2; ++qt) {
        float lt = lsum[qt]; lt += __shfl_xor(lt, 16); lt += __shfl_xor(lt, 32);
        const float inv = 1.0f / lt;
        bf16_t* orow = dummy ? dummy + (rowbase + qt * 16 + l16) * D + h * 128 + kg * 4 : proj + (rowbase + qt * 16 + l16) * PW + C_Q + h * 128 + kg * 4;
#pragma unroll
        for (int dt = 0; dt < 8; ++dt) { const f32x4 v = o[dt][qt] * inv; u32x2 w; w.x = cvt_pk_bf16(v[0], v[1]); w.y = cvt_pk_bf16(v[2], v[3]); *(u32x2*)(orow + dt * 16) = w; }
    }
}

template <int DIR>
__device__ __forceinline__ void rnn_item(LAS unsigned char* lds, const bf16_t* proj, bf16_t* hout, int hpitch, int layer, int s, int n) {
    const int tid = TID(), w = tid >> 6, lane = tid & 63, l16 = lane & 15, kg = lane >> 4;
    const bf16_t* wg = (const bf16_t*)(PWS() + OFF_W + W_RG) + ((size_t)(DIR * 8 + n) * 256) * 128;
    bf16x8 bfr[2][4];
#pragma unroll
    for (int g2 = 0; g2 < 2; ++g2)
#pragma unroll
        for (int ks = 0; ks < 4; ++ks) bfr[g2][ks] = *(const bf16x8*)(wg + (size_t)(g2 * 128 + w * 16 + l16) * 128 + ks * 32 + kg * 8);
    const int ch = n * 128 + w * 16 + l16;
    const float nba = -LOG2E * PIN(11)[(layer * 2 + DIR) * 1024 + ch], nbx = -LOG2E * PIN(13)[(layer * 2 + DIR) * 1024 + ch];
    const float lamv = PIN(9)[(layer * 2 + DIR) * 1024 + ch];
    const float clam2 = -8.0f * LOG2E * log1pf(expf(-lamv));
    const int cgi = tid & 15, tg = tid >> 4;
    LAS unsigned char* RAW = lds;
    LAS unsigned char* At = lds + 34304;
    LAS float* CW = (LAS float*)(lds + 69120);
    LAS unsigned char* OUTB = lds + 71680;
    if (tid < 128) { const float* cwp = PIN(7); const float* cbp = PIN(8);
#pragma unroll
        for (int t = 0; t < 4; ++t) CW[t * 128 + tid] = cwp[(layer * 4 + t) * 1024 + n * 128 + tid];
        CW[4 * 128 + tid] = cbp[layer * 1024 + n * 128 + tid]; }
    const size_t seqbase = (size_t)s * SEQ;
    const bf16_t* xrbase = proj + seqbase * PW + C_XR + n * 128;
    constexpr int first = DIR == 0 ? 0 : 127, stp = DIR == 0 ? 1 : -1;
    u32x4 R0[3], R1[3], R2[3];
#define RNN_LOADR(dst, sub) do { const int sub_ = (sub); _Pragma("unroll") for (int i_ = 0; i_ < 3; ++i_) { const int c_ = tid + 512 * i_; const int tok_ = sub_ * 64 - 2 + (c_ >> 4); \
        dst[i_] = (c_ < 1072 && sub_ >= 0 && sub_ < 128 && tok_ >= 0 && tok_ < SEQ) ? *(const u32x4*)(xrbase + (size_t)tok_ * PW + (c_ & 15) * 8) : (u32x4){0u, 0u, 0u, 0u}; } } while (0)
#define RNN_PUT(src, slot) do { _Pragma("unroll") for (int i_ = 0; i_ < 3; ++i_) { const int c_ = tid + 512 * i_; if (c_ < 1072) *(LAS u32x4*)(RAW + (slot) * 17152 + c_ * 16) = src[i_]; } } while (0)
#define RNN_CONV(slot, buf) do { float xv_[5][8]; _Pragma("unroll") for (int i_ = 0; i_ < 5; ++i_) { const u32x4 p_ = *(const LAS u32x4*)(RAW + (slot) * 17152 + (2 * tg + i_) * 256 + cgi * 16); \
            xv_[i_][0] = bf_lo(p_.x); xv_[i_][1] = bf_hi(p_.x); xv_[i_][2] = bf_lo(p_.y); xv_[i_][3] = bf_hi(p_.y); xv_[i_][4] = bf_lo(p_.z); xv_[i_][5] = bf_hi(p_.z); xv_[i_][6] = bf_lo(p_.w); xv_[i_][7] = bf_hi(p_.w); } \
        float cw[4][8], cb[8]; _Pragma("unroll") for (int t_ = 0; t_ < 5; ++t_) { const f32x4 c0_ = *(const LAS f32x4*)(CW + t_ * 128 + cgi * 8), c1_ = *(const LAS f32x4*)(CW + t_ * 128 + cgi * 8 + 4); \
            _Pragma("unroll") for (int j_ = 0; j_ < 4; ++j_) { if (t_ < 4) { cw[t_ & 3][j_] = c0_[j_]; cw[t_ & 3][4 + j_] = c1_[j_]; } else { cb[j_] = c0_[j_]; cb[4 + j_] = c1_[j_]; } } } \
        _Pragma("unroll") for (int tt_ = 0; tt_ < 2; ++tt_) { float y_[8]; _Pragma("unroll") for (int j_ = 0; j_ < 8; ++j_) { float a_ = cb[j_]; _Pragma("unroll") for (int t_ = 0; t_ < 4; ++t_) a_ += cw[t_][j_] * xv_[tt_ + t_][j_]; y_[j_] = a_; } \
            const int row_ = 2 * tg + tt_; u32x4 w_; w_.x = cvt_pk_bf16(y_[0], y_[1]); w_.y = cvt_pk_bf16(y_[2], y_[3]); w_.z = cvt_pk_bf16(y_[4], y_[5]); w_.w = cvt_pk_bf16(y_[6], y_[7]); \
            *(LAS u32x4*)(At + (buf) * 17408 + row_ * 272 + cgi * 16) = w_; } } while (0)
#define RNN_BAR() do { asm volatile("s_waitcnt lgkmcnt(0)" ::: "memory"); __builtin_amdgcn_s_barrier(); asm volatile("" ::: "memory"); } while (0)
    RNN_LOADR(R0, first); RNN_LOADR(R1, first + stp); RNN_LOADR(R2, first + 2 * stp);
    RNN_PUT(R0, 0);
    RNN_BAR();
    RNN_CONV(0, 0);
    RNN_PUT(R1, 1);
#pragma unroll
    for (int i = 0; i < 3; ++i) R0[i] = R2[i];
    RNN_LOADR(R1, first + 3 * stp); RNN_LOADR(R2, first + 4 * stp);
    RNN_BAR();
    float hcarry = 0.f;
    for (int it = 0; it < 128; ++it) {
        const int sub = first + it * stp, buf = it & 1;
        RNN_PUT(R0, buf);
#pragma unroll
        for (int i = 0; i < 3; ++i) { R0[i] = R1[i]; R1[i] = R2[i]; }
        RNN_LOADR(R2, sub + 5 * stp);
        RNN_CONV(buf ^ 1, buf ^ 1);
        f32x4 aA[4], aX[4];
#pragma unroll
        for (int mt = 0; mt < 4; ++mt) { aA[mt] = (f32x4){0.f, 0.f, 0.f, 0.f}; aX[mt] = (f32x4){0.f, 0.f, 0.f, 0.f}; }
#pragma unroll
        for (int ks = 0; ks < 4; ++ks)
#pragma unroll
            for (int mt = 0; mt < 4; ++mt) {
                const bf16x8 af = *(const LAS bf16x8*)(At + buf * 17408 + (mt * 16 + l16) * 272 + ks * 64 + kg * 16);
                aA[mt] = __builtin_amdgcn_mfma_f32_16x16x32_bf16(af, bfr[0][ks], aA[mt], 0, 0, 0);
                aX[mt] = __builtin_amdgcn_mfma_f32_16x16x32_bf16(af, bfr[1][ks], aX[mt], 0, 0, 0);
            }
        {   typedef float f32x2 __attribute__((ext_vector_type(2)));
#pragma unroll
            for (int mt = 0; mt < 4; ++mt)
#pragma unroll
                for (int rp = 0; rp < 2; ++rp) {
                    const LAS unsigned char* xp = At + buf * 17408 + (mt * 16 + kg * 4 + 2 * rp) * 272 + (w * 16 + l16) * 2;
                    const f32x2 xc = {bf_1(*(const LAS bf16_t*)xp), bf_1(*(const LAS bf16_t*)(xp + 272))};
                    const f32x2 xa = {aA[mt][2 * rp], aA[mt][2 * rp + 1]}, xx = {aX[mt][2 * rp], aX[mt][2 * rp + 1]};
                    f32x2 ta = xa * (-LOG2E) + nba, tx = xx * (-LOG2E) + nbx;
                    ta.x = fminf(ta.x, 60.f); ta.y = fminf(ta.y, 60.f); tx.x = fminf(tx.x, 60.f); tx.y = fminf(tx.y, 60.f);
                    f32x2 ea, ex; ea.x = __builtin_amdgcn_exp2f(ta.x); ea.y = __builtin_amdgcn_exp2f(ta.y); ex.x = __builtin_amdgcn_exp2f(tx.x); ex.y = __builtin_amdgcn_exp2f(tx.y);
                    const f32x2 da = ea + 1.0f, dx = ex + 1.0f, dd = da * dx;
                    f32x2 inv; inv.x = __builtin_amdgcn_rcpf(dd.x); inv.y = __builtin_amdgcn_rcpf(dd.y);
                    const f32x2 rr = dx * inv, ii = da * inv, tt = rr * clam2;
                    f32x2 av; av.x = __builtin_amdgcn_exp2f(tt.x); av.y = __builtin_amdgcn_exp2f(tt.y);
                    f32x2 om = 1.0f - av * av; om.x = fmaxf(om.x, 0.f); om.y = fmaxf(om.y, 0.f);
                    f32x2 sq; sq.x = __builtin_amdgcn_sqrtf(om.x); sq.y = __builtin_amdgcn_sqrtf(om.y);
                    const f32x2 bv = sq * (ii * xc);
                    aA[mt][2 * rp] = av.x; aA[mt][2 * rp + 1] = av.y; aX[mt][2 * rp] = bv.x; aX[mt][2 * rp + 1] = bv.y;
                }
        }
#pragma unroll
        for (int mt = 0; mt < 4; ++mt) {
            float pp = 1.f, hh = 0.f;
#pragma unroll
            for (int q = 0; q < 4; ++q) { const int r = DIR == 0 ? q : 3 - q; hh = aA[mt][r] * hh + aX[mt][r]; pp *= aA[mt][r]; aA[mt][r] = pp; aX[mt][r] = hh; }
        }
        float start[4]; float carry = hcarry;
#pragma unroll
        for (int hq = 0; hq < 2; ++hq) {
            float Ar[8], Br[8];
#pragma unroll
            for (int q8 = 0; q8 < 8; ++q8) { const int q = hq * 8 + q8; const int rho = DIR == 0 ? q : 15 - q; const int mt = rho >> 2, kgp = rho & 3; constexpr int re = DIR == 0 ? 3 : 0;
                Ar[q8] = __shfl(aA[mt][re], l16 + 16 * kgp); Br[q8] = __shfl(aX[mt][re], l16 + 16 * kgp); }
#pragma unroll
            for (int q8 = 0; q8 < 8; ++q8) { const int q = hq * 8 + q8; const int rho = DIR == 0 ? q : 15 - q; const int mt = rho >> 2, kgp = rho & 3;
                if (kg == kgp) start[mt] = carry;
                carry = Ar[q8] * carry + Br[q8]; }
        }
        hcarry = carry;
        if (it > 0) {
#pragma unroll
            for (int i = 0; i < 2; ++i) { const int c = tid + 512 * i; const u32x4 v = *(const LAS u32x4*)(OUTB + (buf ^ 1) * 16384 + c * 16);
                *(u32x4*)(hout + (seqbase + (size_t)(sub - stp) * 64 + (c >> 4)) * hpitch + n * 128 + (c & 15) * 8) = v; }
        }
        {   LAS unsigned short* ob = (LAS unsigned short*)(OUTB + buf * 16384 + (kg * 4) * 256 + (w * 16 + l16) * 2);
#pragma unroll
            for (int mt = 0; mt < 4; ++mt)
#pragma unroll
                for (int rp = 0; rp < 2; ++rp) {
                    const float h0 = aX[mt][2 * rp] + aA[mt][2 * rp] * start[mt], h1 = aX[mt][2 * rp + 1] + aA[mt][2 * rp + 1] * start[mt];
                    const unsigned pk = cvt_pk_bf16(h0, h1);
                    ob[(mt * 16 + 2 * rp) * 128] = (unsigned short)(pk & 0xffffu); ob[(mt * 16 + 2 * rp + 1) * 128] = (unsigned short)(pk >> 16);
                }
        }
        RNN_BAR();
    }
    {
#pragma unroll
        for (int i = 0; i < 2; ++i) { const int c = tid + 512 * i; const u32x4 v = *(const LAS u32x4*)(OUTB + (127 & 1) * 16384 + c * 16);
            *(u32x4*)(hout + (seqbase + (size_t)(first + 127 * stp) * 64 + (c >> 4)) * hpitch + n * 128 + (c & 15) * 8) = v; }
    }
#undef RNN_LOADR
#undef RNN_PUT
#undef RNN_CONV
#undef RNN_BAR
}

__device__ __forceinline__ void phase_attn(LAS unsigned char* lds, bf16_t* proj, int layer, int nseq, unsigned* ctr) {
    LAS int* slot = (LAS int*)(lds + LDS_BYTES - 16);
    const int total = nseq * 256;
    const float* biasG = (const float*)(PWS() + OFF_BIAS);
    for (;;) {
        __syncthreads();
        if (TID() == 0) *slot = (int)atomicAdd(ctr, 1u);
        __syncthreads();
        const int idx = *slot;
        if (idx >= total) break;
        attn_unit(lds, proj, biasG, PIN(14) + layer * 8, idx >> 8, (idx >> 2) & 63, (idx >> 1) & 1, idx & 1);
    }
}
__device__ __forceinline__ void rnn_by_id(LAS unsigned char* lds, bf16_t* proj, int layer, int wk) {
    bf16_t* hb = (bf16_t*)(PWS() + OFF_HB);
    if (wk & 1) rnn_item<1>(lds, proj, hb, D, layer, wk >> 4, (wk >> 1) & 7); else rnn_item<0>(lds, proj, proj + C_YR, PW, layer, wk >> 4, (wk >> 1) & 7);
}
__global__ void __launch_bounds__(512) mega(Params p, int ph_lo, int ph_hi) {
    extern __shared__ __attribute__((aligned(16))) unsigned char lds_raw[];
    LAS unsigned char* lds = (LAS unsigned char*)lds_raw;
    if (TID() == 0) { volatile LAS unsigned* xst = (volatile LAS unsigned*)(lds + LDS_BYTES - 32); xst[0] = 0u; xst[1] = 0u; (void)xb_add(&((unsigned*)(PWS() + OFF_BAR))[XB_XCNT(xb_xcc_id())], 1u); }
    __syncthreads();
#ifdef PROBE_PASS_MASK
    constexpr int NPASS = 2;
#else
    constexpr int NPASS = 1;
#endif
    for (int pass = 0; pass < NPASS; ++pass)
    for (int ph = ph_lo; ph < ph_hi; ++ph) {
#ifdef PROBE_PASS_MASK
        if (pass == 0) { const int q_ = ph; const int bit_ = q_ == 0 ? 0 : (q_ == NPC - 1 ? 1 : 2 + (q_ - 1) % K_PER_LAYER); if (!((PROBE_PASS_MASK >> bit_) & 1)) continue; }
#endif
        unsigned char* const wsb = PWS();
        bf16_t* xb = (bf16_t*)(wsb + OFF_XB); bf16_t* proj = (bf16_t*)(wsb + OFF_PROJ); float* ssq = (float*)(wsb + OFF_SSQ);
        unsigned char* wb = wsb + OFF_W; unsigned* ctl = (unsigned*)(wsb + OFF_CTL) + (NPASS - 1 - pass) * 512;
        const int q = ph;
        constexpr int T = T_ALL;
        float* xo = POUT();
        bf16_t* hb = (bf16_t*)(wsb + OFF_HB);
        if (q == 0) { if (EN & 1) phase_pro(PIN(0), PIN(1) - (size_t)T_P * D, T); }
        else if (q == NPC - 1) { if (EN & 1) phase_fin(xo, T); }
        else {
            const int layer = (q - 1) / K_PER_LAYER, kind = (q - 1) % K_PER_LAYER;
            if (kind == K_WCVT) { if (EN & 2) phase_wcvt(lds, layer); }
            else if (kind == K_UP1 || kind == K_UP2) {
                pg8::Gemm g{xb, (const bf16_t*)(wb + (kind == K_UP1 ? W_UP1 : W_UP2)), D, D, T, INW, D};
                pg8::EpiSwiGLU E{ssq, proj};
                pg8::gemm_phase(lds, g, E);
            } else if (kind == K_DN1 || kind == K_DN2 || kind == K_OUT) {
                pg8::Gemm g; pg8::EpiResid E;
                if (kind == K_OUT) { g = pg8::Gemm{hb, (const bf16_t*)(wb + W_OUT), D, D, T, D, D}; E = pg8::EpiResid{xo, xo, xo, xb, ssq, 1.0f}; }
                else { g = pg8::Gemm{proj, (const bf16_t*)(wb + (kind == K_DN1 ? W_DN1 : W_DN2)), DFF, DFF, T, D, DFF};
                       const bool l0 = (kind == K_DN1 && layer == 0); E = pg8::EpiResid{l0 ? PIN(0) : xo, l0 ? PIN(1) - (size_t)T_P * D : xo, xo, xb, ssq, 0.5f}; }
                pg8::gemm_phase(lds, g, E);
            } else if (kind == K_PROJA) {
                pg8::Gemm g{xb, (const bf16_t*)(wb + W_IN), D, D, T, 1024, D};
                pg8::EpiProj E{ssq, proj + C_XR, PW};
                pg8::gemm_phase(lds, g, E);
            } else if (kind == K_PROJ) {
                pg8::Gemm g{xb, (const bf16_t*)(wb + W_IN) + (size_t)1024 * D, D, D, T, 1536, D};
                pg8::EpiProj E{ssq, proj + 1024, PW};
                const int nb = (int)gridDim.x;
                if (nb >= N_RNN_ITEMS + 64) {
                    unsigned* sub = ctl + 256 + layer * 16;
                    if (BID() < N_RNN_ITEMS) { rnn_by_id(lds, proj, layer, BID()); sub_arrive_wait(sub, (unsigned)(nb - N_RNN_ITEMS), false); }
                    else { pg8::gemm_phase(lds, g, E, nb - N_RNN_ITEMS, BID() - N_RNN_ITEMS); sub_arrive_wait(sub, (unsigned)(nb - N_RNN_ITEMS), true); }
                    phase_attn(lds, proj, layer, NSEQ, ctl + layer * 16);
                } else {
                    pg8::gemm_phase(lds, g, E);
                    for (int wk = BID(); wk < N_RNN_ITEMS; wk += nb) { __syncthreads(); rnn_by_id(lds, proj, layer, wk); }
                }
            } else if (kind == K_MIX1) {
                phase_attn(lds, proj, layer, NSEQ, ctl + layer * 16);
            } else if (kind == K_MIX2) {
                pg8::Gemm g{xb, (const bf16_t*)(wb + W_IN) + (size_t)2560 * D, D, D, T, 2048, D};
                pg8::EpiYG E{ssq, proj, hb};
                pg8::gemm_phase(lds, g, E);
            } else if (kind == K_BRA) {
                { pg8::Gemm g{proj + C_Q, (const bf16_t*)(wb + W_BRA), PW, D, T, D, D};
                  pg8::EpiBranch<0> E{proj, hb};
                  pg8::gemm_phase(lds, g, E); }
                { pg8::Gemm g{xb, (const bf16_t*)(wb + W_IN) + (size_t)4608 * D, D, D, T, 1024, D};
                  pg8::EpiProj E{ssq, hb, D};
                  pg8::gemm_phase(lds, g, E); }
            } else {
                pg8::Gemm g{proj + C_YR, (const bf16_t*)(wb + W_BRR), PW, D, T, D, D};
                pg8::EpiBranch<1> E{proj, hb};
                pg8::gemm_phase(lds, g, E);
            }
        }
        if (ph + 1 < ph_hi || pass + 1 < NPASS) {
#ifdef USE_CG_SYNC
            if (true) cg::this_grid().sync();
#else
            if (ph == ph_lo && pass == 0) cg::this_grid().sync();
#endif
            else xcd_barrier((unsigned*)(PWS() + OFF_BAR), (volatile LAS unsigned*)(lds + LDS_BYTES - 32));
        }
#ifdef PROBE_SYNC3
        if (ph + 1 < ph_hi) { cg::this_grid().sync(); cg::this_grid().sync(); }
#endif
    }
}

extern "C" void kernel_launch(void* const* d_in, const int* in_sizes, int n_in, void* d_out, int out_size, void* d_ws, size_t ws_size, hipStream_t stream) {
    static int grid = 0;
    if (grid == 0) {
        if (n_in != 23 || ws_size < WS_NEED) { fprintf(stderr, "kernel_launch: need 23 inputs and %zu bytes of workspace (got %d, %zu)\n", (size_t)WS_NEED, n_in, ws_size); grid = -1; return; }
        int dev = 0, cus = 0, per_cu = 0;
        hipGetDevice(&dev);
        hipDeviceGetAttribute(&cus, hipDeviceAttributeMultiprocessorCount, dev);
        if (hipFuncSetAttribute((const void*)mega, hipFuncAttributeMaxDynamicSharedMemorySize, LDS_BYTES) != hipSuccess) { fprintf(stderr, "hipFuncSetAttribute failed\n"); grid = -1; return; }
        hipOccupancyMaxActiveBlocksPerMultiprocessor(&per_cu, (const void*)mega, 512, LDS_BYTES);
        if (per_cu < 1) { fprintf(stderr, "occupancy query says %d blocks/CU\n", per_cu); per_cu = 1; }
        (void)hipGetLastError();
        grid = cus * 1;
    }
    if (grid < 0) return;
    hipMemsetAsync((char*)d_ws + OFF_CTL, 0, 4096, stream);
    hipMemsetAsync((char*)d_ws + OFF_BAR, 0, 16384, stream);
    Params p{};
    for (int i = 0; i < 23; ++i) p.in[i] = (const float*)d_in[i];
    p.out = (float*)d_out; p.ws = (unsigned char*)d_ws;
#if PER_PHASE_LAUNCH
    for (int ph = 0; ph < NPH; ++ph) hipLaunchKernelGGL(mega, dim3(grid), dim3(512), LDS_BYTES, stream, p, ph, ph + 1);
#else
    int lo = 0, hi = NPH;
    void* args[] = {&p, &lo, &hi};
    hipError_t e = hipLaunchCooperativeKernel((const void*)mega, dim3(grid), dim3(512), args, LDS_BYTES, stream);
    if (e != hipSuccess) fprintf(stderr, "cooperative launch failed: %s (grid %d)\n", hipGetErrorString(e), grid);
#endif
}
```

```cpp
#include <hip/hip_runtime.h>
#include <hip/hip_cooperative_groups.h>
#include <cstdio>
#include <cstdint>
namespace cg = cooperative_groups;

#ifndef PER_PHASE_LAUNCH
#define PER_PHASE_LAUNCH 0
#endif

#ifndef PROBE_SKIP
#define PROBE_SKIP 0
#endif
#ifndef EN
#define EN 0xffff
#endif
#define LAS __attribute__((address_space(3)))
typedef unsigned short bf16_t;
typedef short bf16x8 __attribute__((ext_vector_type(8)));
typedef float f32x4 __attribute__((ext_vector_type(4)));
typedef unsigned u32x4 __attribute__((ext_vector_type(4)));
typedef unsigned u32x2 __attribute__((ext_vector_type(2)));

constexpr int D = 1024, DFF = 2816, INW = 5632, SEQ = 8192, DEPTH = 4;
constexpr int T_P = 16384, T_ALL = 81920, T_MAX = 81920, NSEQ = 10, PW = 3584;
constexpr int C_XR = 0, C_Q = 1024, C_K = 2048, C_V = 2304, C_YR = 2560;
constexpr int N_RNN_ITEMS = 160;
constexpr float LOG2E = 1.4426950408889634f;

constexpr size_t OFF_CTL = 0;
constexpr size_t OFF_BIAS = 4096;
constexpr size_t OFF_SSQ = 16384;
constexpr size_t OFF_W = OFF_SSQ + (size_t)T_MAX * 16 * 4;
constexpr size_t W_UP1 = 0;
constexpr size_t W_DN1 = W_UP1 + (size_t)INW * D * 2;
constexpr size_t W_IN = W_DN1 + (size_t)D * DFF * 2;
constexpr size_t W_BRA = W_IN + (size_t)INW * D * 2;
constexpr size_t W_BRR = W_BRA + (size_t)D * D * 2;
constexpr size_t W_OUT = W_BRR + (size_t)D * D * 2;
constexpr size_t W_UP2 = W_OUT + (size_t)D * D * 2;
constexpr size_t W_DN2 = W_UP2 + (size_t)INW * D * 2;
constexpr size_t W_RG = W_DN2 + (size_t)D * DFF * 2;
constexpr size_t W_END = W_RG + (size_t)2 * 8 * 256 * 128 * 2;
constexpr size_t OFF_XB = OFF_W + W_END;
constexpr size_t OFF_PROJ = OFF_XB + (size_t)T_MAX * D * 2;
constexpr size_t OFF_HB = OFF_PROJ + (size_t)T_MAX * PW * 2;
constexpr size_t OFF_BAR = OFF_HB + (size_t)T_MAX * D * 2;
constexpr size_t WS_NEED = OFF_BAR + 16384;
constexpr int LDS_BYTES = 132 * 1024;

enum { K_WCVT = 0, K_UP1, K_DN1, K_PROJA, K_PROJ, K_MIX1, K_MIX2, K_BRA, K_BRR, K_OUT, K_UP2, K_DN2, K_PER_LAYER };
constexpr int NPC = 1 + DEPTH * K_PER_LAYER + 1;
constexpr int NPH = NPC;

__constant__ unsigned char c_bucket[257] = {
15,15,15,15,15,15,15,15,15,15,15,15,15,15,15,15,15,15,15,15,15,15,15,15,15,15,15,15,15,15,15,15,15,15,15,15,15,15,14,14,14,14,14,14,14,14,14,14,14,14,14,14,14,14,14,14,14,14,14,14,14,14,14,14,14,13,13,13,13,13,13,13,13,13,13,13,13,13,13,13,13,13,13,12,12,12,12,12,12,12,12,12,12,12,12,12,12,11,11,11,11,11,11,11,11,11,10,10,10,10,10,10,10,9,9,9,9,8,8,8,8,7,6,5,4,3,2,1,0,17,18,19,20,21,22,23,24,24,24,24,25,25,25,25,26,26,26,26,26,26,26,27,27,27,27,27,27,27,27,27,28,28,28,28,28,28,28,28,28,28,28,28,28,28,29,29,29,29,29,29,29,29,29,29,29,29,29,29,29,29,29,29,30,30,30,30,30,30,30,30,30,30,30,30,30,30,30,30,30,30,30,30,30,30,30,30,30,30,30,31,31,31,31,31,31,31,31,31,31,31,31,31,31,31,31,31,31,31,31,31,31,31,31,31,31,31,31,31,31,31,31,31,31,31,31,31,31};

struct Params { const float* in[23]; float* out; unsigned char* ws; };
typedef const volatile __attribute__((address_space(4))) unsigned long long* kargp_t;
__device__ __forceinline__ unsigned long long KARG(int i) { kargp_t kp = (kargp_t)__builtin_amdgcn_kernarg_segment_ptr(); const unsigned long long v = kp[i];
    const unsigned lo = __builtin_amdgcn_readfirstlane((unsigned)v), hi = __builtin_amdgcn_readfirstlane((unsigned)(v >> 32)); return ((unsigned long long)hi << 32) | lo; }
__device__ __forceinline__ const float* PIN(int i) { return (const float*)KARG(i); }
__device__ __forceinline__ float* POUT() { return (float*)KARG(23); }
__device__ __forceinline__ unsigned char* PWS() { return (unsigned char*)KARG(24); }
__device__ __forceinline__ int TID() { int t = threadIdx.x; asm volatile("" : "+v"(t)); return t; }
__device__ __forceinline__ int BID() { int b = blockIdx.x; asm volatile("" : "+s"(b)); return b; }
__device__ __forceinline__ unsigned cvt_pk_bf16(float lo, float hi) { unsigned r; asm volatile("v_cvt_pk_bf16_f32 %0, %1, %2" : "=v"(r) : "v"(lo), "v"(hi)); return r; }
__device__ __forceinline__ float bf_lo(unsigned w) { return __uint_as_float(w << 16); }
__device__ __forceinline__ float bf_hi(unsigned w) { return __uint_as_float(w & 0xffff0000u); }
__device__ __forceinline__ float bf_1(bf16_t h) { return __uint_as_float(((unsigned)h) << 16); }
__device__ __forceinline__ float fast_sigmoid(float x) { return __builtin_amdgcn_rcpf(1.0f + __expf(-x)); }
__device__ __forceinline__ float row_rs(const float* ssq, int row) {
    const f32x4* p = (const f32x4*)(ssq + (size_t)row * 16);
    const f32x4 a = p[0], b = p[1], c = p[2], d = p[3];
    const float s = (((a[0] + a[1]) + (a[2] + a[3])) + ((b[0] + b[1]) + (b[2] + b[3]))) + (((c[0] + c[1]) + (c[2] + c[3])) + ((d[0] + d[1]) + (d[2] + d[3])));
    return __builtin_amdgcn_rsqf(s * (1.0f / 1024.0f) + 1e-6f);
}


__device__ __forceinline__ float row_rs4(const float* ssq, int row, int fq) {
    const f32x4 a = *(const f32x4*)(ssq + (size_t)row * 16 + fq * 4);
    float s = (a[0] + a[1]) + (a[2] + a[3]);
    s += __shfl_xor(s, 16); s += __shfl_xor(s, 32);
    return __builtin_amdgcn_rsqf(s * (1.0f / 1024.0f) + 1e-6f);
}

#define XB_TMO      128
#define XB_XCNT(j)  (256  + 64 * (j))
#define XB_XSUB(j)  (1280 + 64 * (j))
#define XB_XGEN(j)  (2304 + 64 * (j))
#define XB_TOP      3328
#define XB_TOPGEN   3392
#define XCD_BAR_WORDS 3456
#define XB_SPIN_CAP (1u << 22)
__device__ __forceinline__ unsigned xb_ld(unsigned* p)              { return __hip_atomic_load(p, __ATOMIC_RELAXED, __HIP_MEMORY_SCOPE_AGENT); }
__device__ __forceinline__ unsigned xb_add(unsigned* p, unsigned v) { return __hip_atomic_fetch_add(p, v, __ATOMIC_RELAXED, __HIP_MEMORY_SCOPE_AGENT); }
__device__ __forceinline__ unsigned xb_xcc_id() { return (unsigned)__builtin_amdgcn_s_getreg((3 << 11) | 20) & 0xFu; }
#define XB_SPIN(cond, bar) do { unsigned _sp = 0; while (cond) { __builtin_amdgcn_s_sleep(1); \
    if ((++_sp & 255u) == 0u) { if (xb_ld(&(bar)[XB_TMO])) break; if (_sp > XB_SPIN_CAP) { atomicAdd(&(bar)[XB_TMO], 1u); break; } } } } while (0)
__device__ __forceinline__ void xcd_barrier_complete(unsigned* bar, unsigned x, unsigned& nloc, unsigned& nx) {
    const unsigned G = gridDim.x;
    unsigned sum, cnt, mine, sp = 0u;
    for (;;) {
        sum = 0u; cnt = 0u; mine = 0u;
#pragma unroll
        for (unsigned j = 0; j < 16; ++j) { const unsigned c = xb_ld(&bar[XB_XCNT(j)]); sum += c; cnt += (c > 0u) ? 1u : 0u; mine = (j == x) ? c : mine; }
        if (sum == G) break;
        __builtin_amdgcn_s_sleep(1);
        if ((++sp & 255u) == 0u) { if (xb_ld(&bar[XB_TMO])) break; if (sp > XB_SPIN_CAP) { atomicAdd(&bar[XB_TMO], 1u); break; } }
    }
    nloc = mine > 0u ? mine : 1u; nx = cnt > 0u ? cnt : 1u;
}
__device__ __forceinline__ void xcd_barrier(unsigned* bar, volatile LAS unsigned* st) {
    asm volatile("s_waitcnt vmcnt(0)" ::: "memory");
    __syncthreads();
    if (TID() == 0) {
        const unsigned x = xb_xcc_id();
        __builtin_amdgcn_s_waitcnt(0);
        unsigned nloc = st[0], nx = st[1];
        if (nloc == 0u) { xcd_barrier_complete(bar, x, nloc, nx); st[0] = nloc; st[1] = nx; }
        const unsigned old = xb_add(&bar[XB_XSUB(x)], 1u);
        const unsigned gen = old / nloc;
        if (old + 1u == (gen + 1u) * nloc) {
            __builtin_amdgcn_fence(__ATOMIC_RELEASE, "agent");
            asm volatile("s_waitcnt vmcnt(0)" ::: "memory");
            const unsigned og = xb_add(&bar[XB_TOP], 1u);
            const unsigned tg = og / nx;
            if (og + 1u == (tg + 1u) * nx) xb_add(&bar[XB_TOPGEN], 1u);
            else XB_SPIN(xb_ld(&bar[XB_TOPGEN]) == tg, bar);
            __builtin_amdgcn_fence(__ATOMIC_ACQUIRE, "agent");
            xb_add(&bar[XB_XGEN(x)], 1u);
            asm volatile("s_waitcnt vmcnt(0)" ::: "memory");
        } else {
            XB_SPIN(xb_ld(&bar[XB_XGEN(x)]) == gen, bar);
            __builtin_amdgcn_fence(__ATOMIC_ACQUIRE, "agent");
            asm volatile("s_waitcnt vmcnt(0)" ::: "memory");
        }
    }
    __syncthreads();
}

__device__ __forceinline__ void sub_arrive_wait(unsigned* cnt, unsigned need, bool arrive) {
    asm volatile("s_waitcnt vmcnt(0)" ::: "memory");
    __syncthreads();
    if (TID() == 0) {
        if (arrive) { __builtin_amdgcn_fence(__ATOMIC_RELEASE, "agent"); asm volatile("s_waitcnt vmcnt(0)" ::: "memory"); (void)xb_add(cnt, 1u); }
        unsigned sp = 0u;
        while (xb_ld(cnt) < need) { __builtin_amdgcn_s_sleep(2); if (++sp > (1u << 24)) break; }
        __builtin_amdgcn_fence(__ATOMIC_ACQUIRE, "agent");
        asm volatile("s_waitcnt vmcnt(0)" ::: "memory");
    }
    __syncthreads();
}

namespace pg8 {
constexpr int BM = 256, BK = 64, HALF = 128, HTB = HALF * BK * 2, STAGE_BYTES = 8 * HTB, NXCD = 8, WGM = 8;
__device__ __forceinline__ int lds_byte(int r, int c) { const int st = (r >> 4) * 2 + (c >> 5), rr = r & 15, cc = c & 31, ob = rr * 64 + cc * 2; return st * 1024 + (ob ^ (((ob >> 9) & 1) << 5)); }
__device__ __forceinline__ void stage_rc(int b, int& R, int& C) { const int st = b / 1024, sb = b % 1024, swz = sb ^ (((sb >> 9) & 1) << 5); R = (st >> 1) * 16 + swz / 64; C = (st & 1) * 32 + (swz % 64) / 2; }
__device__ __forceinline__ int perm32(int rho) { const int n = rho >> 4, i = rho & 15; return 8 * (i >> 2) + 4 * n + (i & 3); }
struct Unit { int pm, pn; };
struct Gemm { const bf16_t* A; const bf16_t* Bt; int lda, ldb, M, N, K; };
struct StaticOrder {
    int nM, nN, nwg, G, c;
    __device__ void init(int M, int N, int G_, int c_) { nM = M / BM; nN = N / BM; nwg = nM * nN; G = G_; c = c_; }
    __device__ bool next(int i, Unit& u) const {
        const long L = (long)i * G + c; if (L >= nwg) return false;
        int wgid = (int)L; { const int q = nwg / NXCD, r = nwg % NXCD, xcd = wgid % NXCD, off = wgid / NXCD; wgid = (xcd < r ? xcd * (q + 1) : r * (q + 1) + (xcd - r) * q) + off; }
        const int nig = WGM * nN, gid = wgid / nig, fm = gid * WGM, gsz = (nM - fm) < WGM ? (nM - fm) : WGM;
        u.pm = fm + ((wgid % nig) % gsz); u.pn = (wgid % nig) / gsz; return true;
    }
};

template <class Epi, bool ALIGN_EPI = true, bool SP2 = true>
__device__ __forceinline__ void gemm_phase(LAS unsigned char* lds, const Gemm g, const Epi& E, int Gw = -1, int cw = 0) {
    const int tid = TID(), wid = __builtin_amdgcn_readfirstlane(tid >> 6), lane = tid & 63, wr = wid >> 2, wc = wid & 3, fr = lane & 15, fq = lane >> 4;
    const int K = g.K, nt = K / BK;
    StaticOrder S; if (Gw < 0) S.init(g.M, g.N, gridDim.x, BID()); else S.init(g.M, g.N, Gw, cw);
    unsigned voffA[2], voffB[2];
#pragma unroll
    for (int i = 0; i < 2; ++i) { int R, C; stage_rc(tid * 16 + i * 8192, R, C);
        const int Rb = Epi::WIDE ? (64 * (R >> 5) + perm32(R & 31)) : (Epi::PERM ? ((R & ~31) + perm32(R & 31)) : R);
        voffA[i] = (unsigned)(R * g.lda + C) * 2u; voffB[i] = (unsigned)(Rb * g.ldb + C) * 2u; }
    const size_t kstep = (size_t)(BK * 2);
    const size_t hstepA = (size_t)HALF * g.lda * 2, hstepB = (size_t)(Epi::WIDE ? 32 : HALF) * g.ldb * 2;
    const size_t tstepA = 2 * hstepA, tstepB = (size_t)BM * g.ldb * 2;
    const unsigned ldsw = (unsigned)wid * 1024u;
    const int aoff = lds_byte(wr * 64 + fr, fq * 8), boff = lds_byte(wc * 32 + fr, fq * 8);
#define PG8_SA(b, h) (((b) * 2 + (h)) * HTB)
#define PG8_SB(b, h) ((4 + (b) * 2 + (h)) * HTB)
#define PG8_STAGE(bufoff, gbase, voff) do { _Pragma("unroll") for (int _i = 0; _i < 2; ++_i) \
        __builtin_amdgcn_global_load_lds((const unsigned*)((const char*)(gbase) + (voff)[_i]), (LAS unsigned*)(lds + (bufoff) + ldsw + _i * 8192), 16, 0, 0); } while (0)
#define PG8_LDA(dst, b, h) do { _Pragma("unroll") for (int m = 0; m < 4; ++m) _Pragma("unroll") for (int k = 0; k < 2; ++k) dst[m][k] = *(const LAS bf16x8*)(lds + PG8_SA(b, h) + aoff + m * 2048 + k * 1024); } while (0)
#define PG8_LDB(dst, b, h) do { _Pragma("unroll") for (int n = 0; n < 2; ++n) _Pragma("unroll") for (int k = 0; k < 2; ++k) dst[n][k] = *(const LAS bf16x8*)(lds + PG8_SB(b, h) + boff + n * 2048 + k * 1024); } while (0)
#define PG8_MMA(ai, bj, At, Bt) do { __builtin_amdgcn_s_setprio(1); _Pragma("unroll") for (int m = 0; m < 4; ++m) _Pragma("unroll") for (int n = 0; n < 2; ++n) _Pragma("unroll") for (int k = 0; k < 2; ++k) \
        acc[ai][bj][m][n] = __builtin_amdgcn_mfma_f32_16x16x32_bf16(Bt[n][k], At[m][k], acc[ai][bj][m][n], 0, 0, 0); __builtin_amdgcn_s_setprio(0); } while (0)
#define PG8_WAIT_V(n) asm volatile("s_waitcnt vmcnt(" #n ")" ::: "memory")
#define PG8_WAIT_L(n) asm volatile("s_waitcnt lgkmcnt(" #n ")" ::: "memory")
#define PG8_BAR __builtin_amdgcn_s_barrier()
#define PG8_SCHED __builtin_amdgcn_sched_barrier(0)
    Unit cur, nxt; int ui = 0;
    if (!S.next(0, cur)) return;
    f32x4 acc[2][2][4][2];
#pragma unroll
    for (int a = 0; a < 2; ++a)
#pragma unroll
        for (int b = 0; b < 2; ++b)
#pragma unroll
            for (int m = 0; m < 4; ++m)
#pragma unroll
                for (int n = 0; n < 2; ++n) acc[a][b][m][n] = (f32x4){0.f, 0.f, 0.f, 0.f};
    bf16x8 At[4][2], B0[2][2], B1[2][2];
    const char* cA = (const char*)g.A + (size_t)cur.pm * tstepA; const char* cB = (const char*)g.Bt + (size_t)cur.pn * tstepB;
    if constexpr (SP2) {
        PG8_STAGE(PG8_SB(0, 0), cB, voffB); PG8_STAGE(PG8_SB(0, 1), cB + hstepB, voffB); PG8_STAGE(PG8_SA(0, 0), cA, voffA); PG8_STAGE(PG8_SA(0, 1), cA + hstepA, voffA);
        if (wr == 1) PG8_BAR;
        PG8_WAIT_V(2); PG8_BAR;
        PG8_STAGE(PG8_SB(1, 0), cB + kstep, voffB); PG8_STAGE(PG8_SA(1, 0), cA + kstep, voffA); PG8_STAGE(PG8_SB(1, 1), cB + hstepB + kstep, voffB);
        PG8_WAIT_V(6); PG8_BAR;
    } else {
    PG8_STAGE(PG8_SB(0, 0), cB, voffB); PG8_STAGE(PG8_SA(0, 0), cA, voffA); PG8_STAGE(PG8_SB(0, 1), cB + hstepB, voffB); PG8_STAGE(PG8_SA(0, 1), cA + hstepA, voffA);
    if (wr == 1) PG8_BAR;
    PG8_WAIT_V(4); PG8_BAR;
    PG8_STAGE(PG8_SB(1, 0), cB + kstep, voffB); PG8_STAGE(PG8_SA(1, 0), cA + kstep, voffA); PG8_STAGE(PG8_SB(1, 1), cB + hstepB + kstep, voffB);
    PG8_WAIT_V(6); PG8_BAR;
    }
    for (;;) {
        const bool has_next = S.next(ui + 1, nxt);
        const char* nA = has_next ? (const char*)g.A + (size_t)nxt.pm * tstepA : cA; const char* nB = has_next ? (const char*)g.Bt + (size_t)nxt.pn * tstepB : cB;
        for (int t = 0; t < nt; t += 2) {
            const bool last = (t == nt - 2);
            const char* a1 = cA + (size_t)(t + 1) * kstep;
            const char* a2 = last ? nA : cA + (size_t)(t + 2) * kstep; const char* b2 = last ? nB : cB + (size_t)(t + 2) * kstep;
            const char* a3 = a2 + kstep; const char* b3 = b2 + kstep;
            if constexpr (SP2) {
            PG8_LDB(B0, 0, 0); PG8_LDB(B1, 0, 1); PG8_SCHED; PG8_LDA(At, 0, 0); PG8_STAGE(PG8_SA(1, 1), a1 + hstepA, voffA);
            PG8_WAIT_V(8); PG8_WAIT_L(0); PG8_BAR; PG8_MMA(0, 0, At, B0); PG8_MMA(0, 1, At, B1); PG8_BAR; PG8_SCHED;
            PG8_LDA(At, 0, 1); PG8_STAGE(PG8_SB(0, 0), b2, voffB); PG8_STAGE(PG8_SB(0, 1), b2 + hstepB, voffB); PG8_STAGE(PG8_SA(0, 0), a2, voffA);
            PG8_WAIT_V(8); PG8_WAIT_L(0); PG8_BAR; PG8_MMA(1, 0, At, B0); PG8_MMA(1, 1, At, B1); PG8_BAR; PG8_SCHED;
            PG8_LDB(B0, 1, 0); PG8_LDB(B1, 1, 1); PG8_SCHED; PG8_LDA(At, 1, 0); PG8_STAGE(PG8_SA(0, 1), a2 + hstepA, voffA);
            PG8_WAIT_V(8); PG8_WAIT_L(0); PG8_BAR; PG8_MMA(0, 0, At, B0); PG8_MMA(0, 1, At, B1); PG8_BAR; PG8_SCHED;
            PG8_LDA(At, 1, 1); PG8_STAGE(PG8_SB(1, 0), b3, voffB); PG8_STAGE(PG8_SB(1, 1), b3 + hstepB, voffB); PG8_STAGE(PG8_SA(1, 0), a3, voffA);
            PG8_WAIT_V(8); PG8_WAIT_L(0); PG8_BAR; PG8_MMA(1, 0, At, B0); PG8_MMA(1, 1, At, B1); PG8_BAR; PG8_SCHED;
            } else {
            PG8_LDB(B0, 0, 0); PG8_SCHED; PG8_LDA(At, 0, 0); PG8_STAGE(PG8_SA(1, 1), a1 + hstepA, voffA);
            PG8_WAIT_L(8); PG8_BAR; PG8_WAIT_L(0); PG8_MMA(0, 0, At, B0); PG8_BAR; PG8_SCHED;
            PG8_LDB(B1, 0, 1); PG8_STAGE(PG8_SB(0, 0), b2, voffB);
            PG8_BAR; PG8_WAIT_L(0); PG8_MMA(0, 1, At, B1); PG8_BAR;
            PG8_LDA(At, 0, 1); PG8_STAGE(PG8_SA(0, 0), a2, voffA);
            PG8_BAR; PG8_WAIT_L(0); PG8_MMA(1, 0, At, B0); PG8_BAR; PG8_SCHED;
            PG8_STAGE(PG8_SB(0, 1), b2 + hstepB, voffB);
            PG8_WAIT_V(6); PG8_BAR; PG8_MMA(1, 1, At, B1); PG8_BAR;
            PG8_LDB(B0, 1, 0); PG8_SCHED; PG8_LDA(At, 1, 0); PG8_STAGE(PG8_SA(0, 1), a2 + hstepA, voffA);
            PG8_WAIT_L(8); PG8_BAR; PG8_WAIT_L(0); PG8_MMA(0, 0, At, B0); PG8_BAR; PG8_SCHED;
            PG8_LDB(B1, 1, 1); PG8_STAGE(PG8_SB(1, 0), b3, voffB);
            PG8_BAR; PG8_WAIT_L(0); PG8_MMA(0, 1, At, B1); PG8_BAR;
            PG8_LDA(At, 1, 1); PG8_STAGE(PG8_SA(1, 0), a3, voffA);
            PG8_BAR; PG8_WAIT_L(0); PG8_MMA(1, 0, At, B0); PG8_BAR; PG8_SCHED;
            PG8_STAGE(PG8_SB(1, 1), b3 + hstepB, voffB);
            PG8_WAIT_V(6); PG8_BAR; PG8_MMA(1, 1, At, B1); PG8_BAR;
            }
        }
        if constexpr (ALIGN_EPI) { if (wr == 0) PG8_BAR; }
        E(acc, cur, wr, wc, fr, fq);
        if (!has_next) break;
#pragma unroll
        for (int a = 0; a < 2; ++a)
#pragma unroll
            for (int b = 0; b < 2; ++b)
#pragma unroll
                for (int m = 0; m < 4; ++m)
#pragma unroll
                    for (int n = 0; n < 2; ++n) acc[a][b][m][n] = (f32x4){0.f, 0.f, 0.f, 0.f};
        cur = nxt; cA = nA; cB = nB; ++ui;
        if constexpr (ALIGN_EPI) { if (wr == 1) PG8_BAR; }
    }
    PG8_WAIT_V(0);
    if constexpr (!ALIGN_EPI) { if (wr == 0) PG8_BAR; }
    PG8_BAR;
#undef PG8_SA
#undef PG8_SB
#undef PG8_STAGE
#undef PG8_LDA
#undef PG8_LDB
#undef PG8_MMA
#undef PG8_WAIT_V
#undef PG8_WAIT_L
#undef PG8_BAR
#undef PG8_SCHED
}

struct EpiSwiGLU {
    static constexpr bool PERM = true, WIDE = false;
    const float* ssq; bf16_t* mid;
    __device__ __forceinline__ void operator()(const f32x4 (&acc)[2][2][4][2], const Unit& u, int wr, int wc, int fr, int fq) const {
        const int row0 = u.pm * BM + wr * 64 + fr, col0 = u.pn * 128 + wc * 32 + 8 * fq;
#pragma unroll
        for (int ai = 0; ai < 2; ++ai)
#pragma unroll
            for (int m = 0; m < 4; ++m) {
                const int row = row0 + ai * HALF + m * 16; const float rs = row_rs4(ssq, row, fq), rs2 = rs * rs, nrs = -LOG2E * rs;
                float o[8];
#pragma unroll
                for (int n = 0; n < 2; ++n)
#pragma unroll
                    for (int j = 0; j < 4; ++j) {
                        const float g = acc[ai][0][m][n][j], uu = acc[ai][1][m][n][j];
                        o[n * 4 + j] = (g * uu) * rs2 * __builtin_amdgcn_rcpf(1.0f + __builtin_amdgcn_exp2f(g * nrs)); }
                u32x4 w; w.x = cvt_pk_bf16(o[0], o[1]); w.y = cvt_pk_bf16(o[2], o[3]); w.z = cvt_pk_bf16(o[4], o[5]); w.w = cvt_pk_bf16(o[6], o[7]);
                *(u32x4*)(mid + (size_t)row * DFF + col0) = w;
            }
    }
};
struct EpiResid {
    static constexpr bool PERM = true, WIDE = false;
    const float* xin; const float* xin_hi; float* xout; bf16_t* xb; float* ssq; float scale;
    __device__ __forceinline__ void operator()(const f32x4 (&acc)[2][2][4][2], const Unit& u, int wr, int wc, int fr, int fq) const {
        const int row0 = u.pm * BM + wr * 64 + fr, col0 = u.pn * BM + wc * 32 + 8 * fq;
        const float* xin = (u.pm * BM < T_P) ? this->xin : xin_hi;
#pragma unroll
        for (int ai = 0; ai < 2; ++ai)
#pragma unroll
            for (int m = 0; m < 4; ++m) {
                const int row = row0 + ai * HALF + m * 16; const size_t off = (size_t)row * D + col0; float ss = 0.f;
#pragma unroll
                for (int bj = 0; bj < 2; ++bj) {
                    const f32x4 xo0 = *(const f32x4*)(xin + off + bj * HALF), xo1 = *(const f32x4*)(xin + off + bj * HALF + 4);
                    const f32x4 xn0 = xo0 + acc[ai][bj][m][0] * scale, xn1 = xo1 + acc[ai][bj][m][1] * scale;
                    *(f32x4*)(xout + off + bj * HALF) = xn0; *(f32x4*)(xout + off + bj * HALF + 4) = xn1;
                    ss += ((xn0[0] * xn0[0] + xn0[1] * xn0[1]) + (xn0[2] * xn0[2] + xn0[3] * xn0[3])) + ((xn1[0] * xn1[0] + xn1[1] * xn1[1]) + (xn1[2] * xn1[2] + xn1[3] * xn1[3]));
                    u32x4 w; w.x = cvt_pk_bf16(xn0[0], xn0[1]); w.y = cvt_pk_bf16(xn0[2], xn0[3]); w.z = cvt_pk_bf16(xn1[0], xn1[1]); w.w = cvt_pk_bf16(xn1[2], xn1[3]);
                    *(u32x4*)(xb + off + bj * HALF) = w;
                }
                ss += __shfl_xor(ss, 16); ss += __shfl_xor(ss, 32);
                if (fq == 0) ssq[(size_t)row * 16 + u.pn * 4 + wc] = ss;
                if (m == 3) asm volatile("" ::: "memory");
            }
    }
};
struct EpiProj {
    static constexpr bool PERM = true, WIDE = true;
    const float* ssq; bf16_t* proj; int pitch;
    __device__ __forceinline__ void operator()(const f32x4 (&acc)[2][2][4][2], const Unit& u, int wr, int wc, int fr, int fq) const {
        const int row0 = u.pm * BM + wr * 64 + fr, col0 = u.pn * BM + wc * 64 + 8 * fq;
#pragma unroll
        for (int ai = 0; ai < 2; ++ai)
#pragma unroll
            for (int m = 0; m < 4; ++m) {
                const int row = row0 + ai * HALF + m * 16; const float rs = row_rs4(ssq, row, fq);
#pragma unroll
                for (int bj = 0; bj < 2; ++bj) {
                    const f32x4 v0 = acc[ai][bj][m][0] * rs, v1 = acc[ai][bj][m][1] * rs;
                    u32x4 w; w.x = cvt_pk_bf16(v0[0], v0[1]); w.y = cvt_pk_bf16(v0[2], v0[3]); w.z = cvt_pk_bf16(v1[0], v1[1]); w.w = cvt_pk_bf16(v1[2], v1[3]);
                    *(u32x4*)(proj + (size_t)row * pitch + col0 + bj * 32) = w;
                }
            }
    }
};
struct EpiYG {
    static constexpr bool PERM = true, WIDE = true;
    const float* ssq; bf16_t* proj; const bf16_t* hb;
    __device__ __forceinline__ void operator()(const f32x4 (&acc)[2][2][4][2], const Unit& u, int wr, int wc, int fr, int fq) const {
        const int row0 = u.pm * BM + wr * 64 + fr, col0 = (u.pn & 3) * BM + wc * 64 + 8 * fq;
        const bool isy = u.pn < 4;
#pragma unroll
        for (int ai = 0; ai < 2; ++ai)
#pragma unroll
            for (int m = 0; m < 4; ++m) {
                const int row = row0 + ai * HALF + m * 16; const float rs = row_rs4(ssq, row, fq);
#pragma unroll
                for (int bj = 0; bj < 2; ++bj) {
                    float o[8];
#pragma unroll
                    for (int n = 0; n < 2; ++n)
#pragma unroll
                        for (int j = 0; j < 4; ++j) o[n * 4 + j] = acc[ai][bj][m][n][j] * rs;
                    bf16_t* dst = proj + (size_t)row * PW + (isy ? C_YR : C_XR) + col0 + bj * 32;
                    if (isy) {
                        const u32x4 fw = *(const u32x4*)dst; const u32x4 bw = *(const u32x4*)(hb + (size_t)row * D + col0 + bj * 32);
                        const float hs[8] = {bf_lo(fw.x) + bf_lo(bw.x), bf_hi(fw.x) + bf_hi(bw.x), bf_lo(fw.y) + bf_lo(bw.y), bf_hi(fw.y) + bf_hi(bw.y),
                                             bf_lo(fw.z) + bf_lo(bw.z), bf_hi(fw.z) + bf_hi(bw.z), bf_lo(fw.w) + bf_lo(bw.w), bf_hi(fw.w) + bf_hi(bw.w)};
#pragma unroll
                        for (int i = 0; i < 8; ++i) { const float y = o[i]; o[i] = hs[i] * y * fast_sigmoid(1.5957691216057308f * (y + 0.044715f * y * y * y)); }
                    }
                    u32x4 w; w.x = cvt_pk_bf16(o[0], o[1]); w.y = cvt_pk_bf16(o[2], o[3]); w.z = cvt_pk_bf16(o[4], o[5]); w.w = cvt_pk_bf16(o[6], o[7]);
                    *(u32x4*)dst = w;
                }
            }
    }
};
template <int SECOND> struct EpiBranch {
    static constexpr bool PERM = true, WIDE = true;
    bf16_t* proj; bf16_t* hb;
    __device__ __forceinline__ void operator()(const f32x4 (&acc)[2][2][4][2], const Unit& u, int wr, int wc, int fr, int fq) const {
        const int row0 = u.pm * BM + wr * 64 + fr, col0 = u.pn * BM + wc * 64 + 8 * fq;
#pragma unroll
        for (int ai = 0; ai < 2; ++ai)
#pragma unroll
            for (int m = 0; m < 4; ++m) {
                const int row = row0 + ai * HALF + m * 16;
#pragma unroll
                for (int bj = 0; bj < 2; ++bj) {
                    bf16_t* pm1 = proj + (size_t)row * PW + C_XR + col0 + bj * 32;
                    bf16_t* pg = SECOND ? hb + (size_t)row * D + col0 + bj * 32 : pm1;
                    const u32x4 gw = *(const u32x4*)pg;
                    float gv[8] = {bf_lo(gw.x), bf_hi(gw.x), bf_lo(gw.y), bf_hi(gw.y), bf_lo(gw.z), bf_hi(gw.z), bf_lo(gw.w), bf_hi(gw.w)};
                    float o[8];
#pragma unroll
                    for (int n = 0; n < 2; ++n)
#pragma unroll
                        for (int j = 0; j < 4; ++j) o[n * 4 + j] = fast_sigmoid(gv[n * 4 + j]) * acc[ai][bj][m][n][j];
                    if (SECOND) {
                        const u32x4 mw = *(const u32x4*)pm1;
                        o[0] += bf_lo(mw.x); o[1] += bf_hi(mw.x); o[2] += bf_lo(mw.y); o[3] += bf_hi(mw.y); o[4] += bf_lo(mw.z); o[5] += bf_hi(mw.z); o[6] += bf_lo(mw.w); o[7] += bf_hi(mw.w);
                    }
                    u32x4 w; w.x = cvt_pk_bf16(o[0], o[1]); w.y = cvt_pk_bf16(o[2], o[3]); w.z = cvt_pk_bf16(o[4], o[5]); w.w = cvt_pk_bf16(o[6], o[7]);
                    *(u32x4*)pg = w;
                }
            }
    }
};
}

template <int MAP>
__device__ __forceinline__ void cvt_item(const float* W, int K, int N, bf16_t* Wt, int ldk, const float* gain, LAS float* scr, int item, int lane) {
    const int nblk = N / 32, kb = item / nblk, nb = item % nblk, k0 = 64 * kb, n0 = 32 * nb;
#pragma unroll 8
    for (int i = 0; i < 32; ++i) { const int kk = 2 * i + (lane >> 5); scr[kk * 33 + (lane & 31)] = W[(size_t)(k0 + kk) * N + n0 + (lane & 31)]; }
    asm volatile("s_waitcnt lgkmcnt(0)" ::: "memory");
    const int c = lane & 7;
    float gk[8];
#pragma unroll
    for (int j = 0; j < 8; ++j) gk[j] = gain ? gain[k0 + 8 * c + j] : 1.0f;
#pragma unroll
    for (int j = 0; j < 4; ++j) { const int n = (lane >> 3) + 8 * j; const LAS float* s = scr + (8 * c) * 33 + n;
        u32x4 o; o.x = cvt_pk_bf16(s[0 * 33] * gk[0], s[1 * 33] * gk[1]); o.y = cvt_pk_bf16(s[2 * 33] * gk[2], s[3 * 33] * gk[3]);
        o.z = cvt_pk_bf16(s[4 * 33] * gk[4], s[5 * 33] * gk[5]); o.w = cvt_pk_bf16(s[6 * 33] * gk[6], s[7 * 33] * gk[7]);
        const int ng = n0 + n; int drow = ng;
        if (MAP == 1) { const int half = ng / DFF, r = ng % DFF; drow = (r / 128) * 256 + half * 128 + (r % 128); }
        if (MAP == 2) { drow = ng < 1536 ? ng + 1024 : (ng < 2560 ? ng - 1536 : ng); }
        *(u32x4*)(Wt + (size_t)drow * ldk + k0 + 8 * c) = o; }
    asm volatile("s_waitcnt lgkmcnt(0)" ::: "memory");
}

__device__ __forceinline__ void phase_wcvt(LAS unsigned char* lds, int layer) {
    const int tid = TID(), wave = tid >> 6, lane = tid & 63;
    LAS float* scr = (LAS float*)(lds + wave * 8704);
    unsigned char* wb = PWS() + OFF_W;
    const int gw = BID() * 8 + wave, NGW = gridDim.x * 8;
    constexpr int I_UP = (D / 64) * (INW / 32), I_DN = (DFF / 64) * (D / 32), I_SQ = (D / 64) * (D / 32), I_RG = 32 * 8;
    constexpr int NIT = 3 * I_UP + 2 * I_DN + 3 * I_SQ + I_RG;
    for (int it = gw; it < NIT; it += NGW) {
        int r = it;
        if (r < I_UP) { cvt_item<1>(PIN(3) + (size_t)layer * D * INW, D, INW, (bf16_t*)(wb + W_UP1), D, PIN(2) + layer * D, scr, r, lane); continue; } r -= I_UP;
        if (r < I_UP) { cvt_item<1>(PIN(20) + (size_t)layer * D * INW, D, INW, (bf16_t*)(wb + W_UP2), D, PIN(19) + layer * D, scr, r, lane); continue; } r -= I_UP;
        if (r < I_UP) { cvt_item<2>(PIN(6) + (size_t)layer * D * INW, D, INW, (bf16_t*)(wb + W_IN), D, PIN(5) + layer * D, scr, r, lane); continue; } r -= I_UP;
        if (r < I_DN) { cvt_item<0>(PIN(4) + (size_t)layer * DFF * D, DFF, D, (bf16_t*)(wb + W_DN1), DFF, nullptr, scr, r, lane); continue; } r -= I_DN;
        if (r < I_DN) { cvt_item<0>(PIN(21) + (size_t)layer * DFF * D, DFF, D, (bf16_t*)(wb + W_DN2), DFF, nullptr, scr, r, lane); continue; } r -= I_DN;
        if (r < I_SQ) { cvt_item<0>(PIN(16) + (size_t)layer * D * D, D, D, (bf16_t*)(wb + W_BRA), D, nullptr, scr, r, lane); continue; } r -= I_SQ;
        if (r < I_SQ) { cvt_item<0>(PIN(17) + (size_t)layer * D * D, D, D, (bf16_t*)(wb + W_BRR), D, nullptr, scr, r, lane); continue; } r -= I_SQ;
        if (r < I_SQ) { cvt_item<0>(PIN(18) + (size_t)layer * D * D, D, D, (bf16_t*)(wb + W_OUT), D, nullptr, scr, r, lane); continue; } r -= I_SQ;
        {
            const int mi = r / 8, sub = r % 8, ax = mi & 1, dn = mi >> 1;
            const float* src = (ax ? PIN(12) : PIN(10)) + ((size_t)layer * 16 + dn) * 128 * 128;
            cvt_item<0>(src, 128, 128, (bf16_t*)(wb + W_RG) + ((size_t)dn * 256 + ax * 128) * 128, 128, nullptr, scr, sub, lane);
        }
    }
}

__device__ __forceinline__ void phase_pro(const float* xin_lo, const float* xin_hi, int T) {
    const int tid = TID(), wave = tid >> 6, lane = tid & 63;
    bf16_t* xb = (bf16_t*)(PWS() + OFF_XB); float* ssq = (float*)(PWS() + OFF_SSQ);
    for (int row = BID() * 8 + wave; row < T; row += gridDim.x * 8) {
        const f32x4* xr = (const f32x4*)((row < T_P ? xin_lo : xin_hi) + (size_t)row * D) + lane;
        float s = 0.f; f32x4 v[4];
#pragma unroll
        for (int j = 0; j < 4; ++j) { v[j] = xr[64 * j]; s += (v[j][0] * v[j][0] + v[j][1] * v[j][1]) + (v[j][2] * v[j][2] + v[j][3] * v[j][3]); }
#pragma unroll
        for (int o = 1; o < 64; o <<= 1) s += __shfl_xor(s, o);
        u32x2* o8 = (u32x2*)(xb + (size_t)row * D) + lane;
#pragma unroll
        for (int j = 0; j < 4; ++j) { u32x2 w; w.x = cvt_pk_bf16(v[j][0], v[j][1]); w.y = cvt_pk_bf16(v[j][2], v[j][3]); o8[64 * j] = w; }
        if (lane < 16) ssq[(size_t)row * 16 + lane] = (lane == 0) ? s : 0.f;
    }
    if (BID() == 0) {
        float* bt = (float*)(PWS() + OFF_BIAS);
        for (int i = tid; i < 8 * 257; i += 512) { const int h = i / 257, r = i % 257; bt[i] = PIN(15)[(int)c_bucket[r] * 8 + h] * LOG2E; }
    }
}
__device__ __forceinline__ void phase_fin(float* x, int T) {
    const int tid = TID(), wave = tid >> 6, lane = tid & 63;
    const float* ssq = (const float*)(PWS() + OFF_SSQ); const f32x4* g4 = (const f32x4*)PIN(22) + lane;
    for (int row = BID() * 8 + wave; row < T; row += gridDim.x * 8) {
        const float rs = row_rs(ssq, row);
        f32x4* xr = (f32x4*)(x + (size_t)row * D) + lane;
#pragma unroll
        for (int j = 0; j < 4; ++j) { f32x4 v = xr[64 * j]; v = v * rs * g4[64 * j]; xr[64 * j] = v; }
    }
}

__device__ __forceinline__ void attn_unit(LAS unsigned char* lds, bf16_t* proj, const float* biasG, const float* sink, int s, int qb, int kh, int hp, bf16_t* dummy = nullptr) {
    const int tid = TID(), w = tid >> 6, lane = tid & 63, l16 = lane & 15, kg = lane >> 4;
    const int hl = w >> 2, h = kh * 4 + hp * 2 + hl, wq = w & 3;
    LAS unsigned char* Ks = lds;
    LAS unsigned char* Vt = lds + 34816;
    LAS float* bL = (LAS float*)(lds + 34816 + 36864);
    for (int i = tid; i < 2 * 257; i += 512) { const int a = i / 257, r = i % 257; bL[a * 260 + r] = biasG[(kh * 4 + hp * 2 + a) * 257 + r]; }
    const size_t seqbase = (size_t)s * SEQ;
    const size_t rowbase = seqbase + (size_t)qb * 128 + wq * 32;
    bf16x8 qf[2][4];
#pragma unroll
    for (int qt = 0; qt < 2; ++qt)
#pragma unroll
        for (int ks = 0; ks < 4; ++ks) qf[qt][ks] = *(const bf16x8*)(proj + (rowbase + qt * 16 + l16) * PW + C_Q + h * 128 + ks * 32 + kg * 8);
    float m2[2], lsum[2]; f32x4 o[8][2];
    { const float sk = sink[h] * LOG2E; m2[0] = sk; m2[1] = sk; lsum[0] = (kg == 0) ? 1.f : 0.f; lsum[1] = lsum[0]; }
#pragma unroll
    for (int dt = 0; dt < 8; ++dt) { o[dt][0] = (f32x4){0.f, 0.f, 0.f, 0.f}; o[dt][1] = (f32x4){0.f, 0.f, 0.f, 0.f}; }
    const float SC = 0.08838834764831845f * LOG2E;
    u32x4 kr[4], vr[4];
#define ATT_LOADKV(kb) do { _Pragma("unroll") for (int i_ = 0; i_ < 4; ++i_) { const int c_ = tid + 512 * i_; const int r_ = c_ >> 4, cc_ = c_ & 15; \
        const bf16_t* src_ = proj + (seqbase + (size_t)(kb) * 128 + r_) * PW + kh * 128 + cc_ * 8; kr[i_] = *(const u32x4*)(src_ + C_K); vr[i_] = *(const u32x4*)(src_ + C_V); } } while (0)
#define ATT_STOREKV() do { _Pragma("unroll") for (int i_ = 0; i_ < 4; ++i_) { const int c_ = tid + 512 * i_; const int r_ = c_ >> 4, cc_ = c_ & 15; \
        *(LAS u32x4*)(Ks + r_ * 272 + cc_ * 16) = kr[i_]; LAS unsigned short* vd_ = (LAS unsigned short*)(Vt + (cc_ * 8) * 288 + r_ * 2); const u32x4 vv_ = vr[i_]; \
        vd_[0 * 144] = (unsigned short)(vv_.x & 0xffff); vd_[1 * 144] = (unsigned short)(vv_.x >> 16); vd_[2 * 144] = (unsigned short)(vv_.y & 0xffff); vd_[3 * 144] = (unsigned short)(vv_.y >> 16); \
        vd_[4 * 144] = (unsigned short)(vv_.z & 0xffff); vd_[5 * 144] = (unsigned short)(vv_.z >> 16); vd_[6 * 144] = (unsigned short)(vv_.w & 0xffff); vd_[7 * 144] = (unsigned short)(vv_.w >> 16); } } while (0)
    const int kb_lo = qb > 0 ? 0 : 1, kb_hi = qb < SEQ / 128 - 1 ? 2 : 1;
    ATT_LOADKV(qb - 1 + kb_lo);
    for (int kbi = kb_lo; kbi <= kb_hi; ++kbi) {
        __syncthreads();
        ATT_STOREKV();
        __syncthreads();
        if (kbi < kb_hi) ATT_LOADKV(qb + kbi);
        for (int si = 0; si < 4; ++si) {
            const int st = kbi * 4 + si;
            if (st < wq || st > wq + 8) continue;
            f32x4 sa[2][2];
#pragma unroll
            for (int kt = 0; kt < 2; ++kt) { sa[kt][0] = (f32x4){0.f, 0.f, 0.f, 0.f}; sa[kt][1] = (f32x4){0.f, 0.f, 0.f, 0.f}; }
#pragma unroll
            for (int ks = 0; ks < 4; ++ks)
#pragma unroll
                for (int kt = 0; kt < 2; ++kt) {
                    const bf16x8 kf = *(const LAS bf16x8*)(Ks + (si * 32 + kt * 16 + l16) * 272 + ks * 64 + kg * 16);
                    sa[kt][0] = __builtin_amdgcn_mfma_f32_16x16x32_bf16(kf, qf[0][ks], sa[kt][0], 0, 0, 0);
                    sa[kt][1] = __builtin_amdgcn_mfma_f32_16x16x32_bf16(kf, qf[1][ks], sa[kt][1], 0, 0, 0);
                }
            bf16x8 pf[2];
#pragma unroll
            for (int qt = 0; qt < 2; ++qt) {
                const int qp = wq * 32 + qt * 16 + l16;
                float sv[8]; float mx = -1e30f;
#pragma unroll
                for (int kt = 0; kt < 2; ++kt)
#pragma unroll
                    for (int r = 0; r < 4; ++r) {
                        const int kp = (kbi - 1) * 128 + si * 32 + kt * 16 + kg * 4 + r;
                        const int rel = kp - qp; const bool valid = (rel >= -128) && (rel <= 128);
                        const int idx = min(max(rel + 128, 0), 256);
                        const float v = valid ? (sa[kt][qt][r] * SC + bL[hl * 260 + idx]) : -1e30f;
                        sv[kt * 4 + r] = v; mx = fmaxf(mx, v);
                    }
                mx = fmaxf(mx, __shfl_xor(mx, 16)); mx = fmaxf(mx, __shfl_xor(mx, 32));
                const float mnew = fmaxf(m2[qt], mx), alpha = __builtin_amdgcn_exp2f(m2[qt] - mnew); m2[qt] = mnew;
                float ps = 0.f; float pv[8];
#pragma unroll
                for (int i = 0; i < 8; ++i) { pv[i] = __builtin_amdgcn_exp2f(sv[i] - mnew); ps += pv[i]; }
                lsum[qt] = lsum[qt] * alpha + ps;
#pragma unroll
                for (int dt = 0; dt < 8; ++dt) o[dt][qt] = o[dt][qt] * alpha;
                u32x4 pw; pw.x = cvt_pk_bf16(pv[0], pv[1]); pw.y = cvt_pk_bf16(pv[2], pv[3]); pw.z = cvt_pk_bf16(pv[4], pv[5]); pw.w = cvt_pk_bf16(pv[6], pv[7]);
                pf[qt] = __builtin_bit_cast(bf16x8, pw);
            }
#pragma unroll
            for (int dt = 0; dt < 8; ++dt) {
                const LAS unsigned char* vr = Vt + (dt * 16 + l16) * 288 + (si * 32 + kg * 4) * 2;
                const u32x2 lo = *(const LAS u32x2*)(vr), hi = *(const LAS u32x2*)(vr + 32);
                u32x4 vw; vw.x = lo.x; vw.y = lo.y; vw.z = hi.x; vw.w = hi.y;
                const bf16x8 vf = __builtin_bit_cast(bf16x8, vw);
                o[dt][0] = __builtin_amdgcn_mfma_f32_16x16x32_bf16(vf, pf[0], o[dt][0], 0, 0, 0);
                o[dt][1] = __builtin_amdgcn_mfma_f32_16x16x32_bf16(vf, pf[1], o[dt][1], 0, 0, 0);
            }
        }
    }
#pragma unroll
    for (int qt = 0; qt < 2; ++qt) {
        float lt = lsum[qt]; lt += __shfl_xor(lt, 16); lt += __shfl_xor(lt, 32);
        const float inv = 1.0f / lt;
        bf16_t* orow = dummy ? dummy + (rowbase + qt * 16 + l16) * D + h * 128 + kg * 4 : proj + (rowbase + qt * 16 + l16) * PW + C_Q + h * 128 + kg * 4;
#pragma unroll
        for (int dt = 0; dt < 8; ++dt) { const f32x4 v = o[dt][qt] * inv; u32x2 w; w.x = cvt_pk_bf16(v[0], v[1]); w.y = cvt_pk_bf16(v[2], v[3]); *(u32x2*)(orow + dt * 16) = w; }
    }
}

template <int DIR>
__device__ __forceinline__ void rnn_item(LAS unsigned char* lds, const bf16_t* proj, bf16_t* hout, int hpitch, int layer, int s, int n) {
    const int tid = TID(), w = tid >> 6, lane = tid & 63, l16 = lane & 15, kg = lane >> 4;
    const bf16_t* wg = (const bf16_t*)(PWS() + OFF_W + W_RG) + ((size_t)(DIR * 8 + n) * 256) * 128;
    bf16x8 bfr[2][4];
#pragma unroll
    for (int g2 = 0; g2 < 2; ++g2)
#pragma unroll
        for (int ks = 0; ks < 4; ++ks) bfr[g2][ks] = *(const bf16x8*)(wg + (size_t)(g2 * 128 + w * 16 + l16) * 128 + ks * 32 + kg * 8);
    const int ch = n * 128 + w * 16 + l16;
    const float nba = -LOG2E * PIN(11)[(layer * 2 + DIR) * 1024 + ch], nbx = -LOG2E * PIN(13)[(layer * 2 + DIR) * 1024 + ch];
    const float lamv = PIN(9)[(layer * 2 + DIR) * 1024 + ch];
    const float clam2 = -8.0f * LOG2E * log1pf(expf(-lamv));
    const int cgi = tid & 15, tg = tid >> 4;
    LAS unsigned char* RAW = lds;
    LAS unsigned char* At = lds + 34304;
    LAS float* CW = (LAS float*)(lds + 69120);
    LAS unsigned char* OUTB = lds + 71680;
    if (tid < 128) { const float* cwp = PIN(7); const float* cbp = PIN(8);
#pragma unroll
        for (int t = 0; t < 4; ++t) CW[t * 128 + tid] = cwp[(layer * 4 + t) * 1024 + n * 128 + tid];
        CW[4 * 128 + tid] = cbp[layer * 1024 + n * 128 + tid]; }
    const size_t seqbase = (size_t)s * SEQ;
    const bf16_t* xrbase = proj + seqbase * PW + C_XR + n * 128;
    constexpr int first = DIR == 0 ? 0 : 127, stp = DIR == 0 ? 1 : -1;
    u32x4 R0[3], R1[3], R2[3];
#define RNN_LOADR(dst, sub) do { const int sub_ = (sub); _Pragma("unroll") for (int i_ = 0; i_ < 3; ++i_) { const int c_ = tid + 512 * i_; const int tok_ = sub_ * 64 - 2 + (c_ >> 4); \
        dst[i_] = (c_ < 1072 && sub_ >= 0 && sub_ < 128 && tok_ >= 0 && tok_ < SEQ) ? *(const u32x4*)(xrbase + (size_t)tok_ * PW + (c_ & 15) * 8) : (u32x4){0u, 0u, 0u, 0u}; } } while (0)
#define RNN_PUT(src, slot) do { _Pragma("unroll") for (int i_ = 0; i_ < 3; ++i_) { const int c_ = tid + 512 * i_; if (c_ < 1072) *(LAS u32x4*)(RAW + (slot) * 17152 + c_ * 16) = src[i_]; } } while (0)
#define RNN_CONV(slot, buf) do { float xv_[5][8]; _Pragma("unroll") for (int i_ = 0; i_ < 5; ++i_) { const u32x4 p_ = *(const LAS u32x4*)(RAW + (slot) * 17152 + (2 * tg + i_) * 256 + cgi * 16); \
            xv_[i_][0] = bf_lo(p_.x); xv_[i_][1] = bf_hi(p_.x); xv_[i_][2] = bf_lo(p_.y); xv_[i_][3] = bf_hi(p_.y); xv_[i_][4] = bf_lo(p_.z); xv_[i_][5] = bf_hi(p_.z); xv_[i_][6] = bf_lo(p_.w); xv_[i_][7] = bf_hi(p_.w); } \
        float cw[4][8], cb[8]; _Pragma("unroll") for (int t_ = 0; t_ < 5; ++t_) { const f32x4 c0_ = *(const LAS f32x4*)(CW + t_ * 128 + cgi * 8), c1_ = *(const LAS f32x4*)(CW + t_ * 128 + cgi * 8 + 4); \
            _Pragma("unroll") for (int j_ = 0; j_ < 4; ++j_) { if (t_ < 4) { cw[t_ & 3][j_] = c0_[j_]; cw[t_ & 3][4 + j_] = c1_[j_]; } else { cb[j_] = c0_[j_]; cb[4 + j_] = c1_[j_]; } } } \
        _Pragma("unroll") for (int tt_ = 0; tt_ < 2; ++tt_) { float y_[8]; _Pragma("unroll") for (int j_ = 0; j_ < 8; ++j_) { float a_ = cb[j_]; _Pragma("unroll") for (int t_ = 0; t_ < 4; ++t_) a_ += cw[t_][j_] * xv_[tt_ + t_][j_]; y_[j_] = a_; } \
            const int row_ = 2 * tg + tt_; u32x4 w_; w_.x = cvt_pk_bf16(y_[0], y_[1]); w_.y = cvt_pk_bf16(y_[2], y_[3]); w_.z = cvt_pk_bf16(y_[4], y_[5]); w_.w = cvt_pk_bf16(y_[6], y_[7]); \
            *(LAS u32x4*)(At + (buf) * 17408 + row_ * 272 + cgi * 16) = w_; } } while (0)
#define RNN_BAR() do { asm volatile("s_waitcnt lgkmcnt(0)" ::: "memory"); __builtin_amdgcn_s_barrier(); asm volatile("" ::: "memory"); } while (0)
    RNN_LOADR(R0, first); RNN_LOADR(R1, first + stp); RNN_LOADR(R2, first + 2 * stp);
    RNN_PUT(R0, 0);
    RNN_BAR();
    RNN_CONV(0, 0);
    RNN_PUT(R1, 1);
#pragma unroll
    for (int i = 0; i < 3; ++i) R0[i] = R2[i];
    RNN_LOADR(R1, first + 3 * stp); RNN_LOADR(R2, first + 4 * stp);
    RNN_BAR();
    float hcarry = 0.f;
    for (int it = 0; it < 128; ++it) {
        const int sub = first + it * stp, buf = it & 1;
        RNN_PUT(R0, buf);
#pragma unroll
        for (int i = 0; i < 3; ++i) { R0[i] = R1[i]; R1[i] = R2[i]; }
        RNN_LOADR(R2, sub + 5 * stp);
        RNN_CONV(buf ^ 1, buf ^ 1);
        f32x4 aA[4], aX[4];
#pragma unroll
        for (int mt = 0; mt < 4; ++mt) { aA[mt] = (f32x4){0.f, 0.f, 0.f, 0.f}; aX[mt] = (f32x4){0.f, 0.f, 0.f, 0.f}; }
#pragma unroll
        for (int ks = 0; ks < 4; ++ks)
#pragma unroll
            for (int mt = 0; mt < 4; ++mt) {
                const bf16x8 af = *(const LAS bf16x8*)(At + buf * 17408 + (mt * 16 + l16) * 272 + ks * 64 + kg * 16);
                aA[mt] = __builtin_amdgcn_mfma_f32_16x16x32_bf16(af, bfr[0][ks], aA[mt], 0, 0, 0);
                aX[mt] = __builtin_amdgcn_mfma_f32_16x16x32_bf16(af, bfr[1][ks], aX[mt], 0, 0, 0);
            }
        {   typedef float f32x2 __attribute__((ext_vector_type(2)));
#pragma unroll
            for (int mt = 0; mt < 4; ++mt)
#pragma unroll
                for (int rp = 0; rp < 2; ++rp) {
                    const LAS unsigned char* xp = At + buf * 17408 + (mt * 16 + kg * 4 + 2 * rp) * 272 + (w * 16 + l16) * 2;
                    const f32x2 xc = {bf_1(*(const LAS bf16_t*)xp), bf_1(*(const LAS bf16_t*)(xp + 272))};
                    const f32x2 xa = {aA[mt][2 * rp], aA[mt][2 * rp + 1]}, xx = {aX[mt][2 * rp], aX[mt][2 * rp + 1]};
                    f32x2 ta = xa * (-LOG2E) + nba, tx = xx * (-LOG2E) + nbx;
                    ta.x = fminf(ta.x, 60.f); ta.y = fminf(ta.y, 60.f); tx.x = fminf(tx.x, 60.f); tx.y = fminf(tx.y, 60.f);
                    f32x2 ea, ex; ea.x = __builtin_amdgcn_exp2f(ta.x); ea.y = __builtin_amdgcn_exp2f(ta.y); ex.x = __builtin_amdgcn_exp2f(tx.x); ex.y = __builtin_amdgcn_exp2f(tx.y);
                    const f32x2 da = ea + 1.0f, dx = ex + 1.0f, dd = da * dx;
                    f32x2 inv; inv.x = __builtin_amdgcn_rcpf(dd.x); inv.y = __builtin_amdgcn_rcpf(dd.y);
                    const f32x2 rr = dx * inv, ii = da * inv, tt = rr * clam2;
                    f32x2 av; av.x = __builtin_amdgcn_exp2f(tt.x); av.y = __builtin_amdgcn_exp2f(tt.y);
                    f32x2 om = 1.0f - av * av; om.x = fmaxf(om.x, 0.f); om.y = fmaxf(om.y, 0.f);
                    f32x2 sq; sq.x = __builtin_amdgcn_sqrtf(om.x); sq.y = __builtin_amdgcn_sqrtf(om.y);
                    const f32x2 bv = sq * (ii * xc);
                    aA[mt][2 * rp] = av.x; aA[mt][2 * rp + 1] = av.y; aX[mt][2 * rp] = bv.x; aX[mt][2 * rp + 1] = bv.y;
                }
        }
#pragma unroll
        for (int mt = 0; mt < 4; ++mt) {
            float pp = 1.f, hh = 0.f;
#pragma unroll
            for (int q = 0; q < 4; ++q) { const int r = DIR == 0 ? q : 3 - q; hh = aA[mt][r] * hh + aX[mt][r]; pp *= aA[mt][r]; aA[mt][r] = pp; aX[mt][r] = hh; }
        }
        float start[4]; float carry = hcarry;
#pragma unroll
        for (int hq = 0; hq < 2; ++hq) {
            float Ar[8], Br[8];
#pragma unroll
            for (int q8 = 0; q8 < 8; ++q8) { const int q = hq * 8 + q8; const int rho = DIR == 0 ? q : 15 - q; const int mt = rho >> 2, kgp = rho & 3; constexpr int re = DIR == 0 ? 3 : 0;
                Ar[q8] = __shfl(aA[mt][re], l16 + 16 * kgp); Br[q8] = __shfl(aX[mt][re], l16 + 16 * kgp); }
#pragma unroll
            for (int q8 = 0; q8 < 8; ++q8) { const int q = hq * 8 + q8; const int rho = DIR == 0 ? q : 15 - q; const int mt = rho >> 2, kgp = rho & 3;
                if (kg == kgp) start[mt] = carry;
                carry = Ar[q8] * carry + Br[q8]; }
        }
        hcarry = carry;
        if (it > 0) {
#pragma unroll
            for (int i = 0; i < 2; ++i) { const int c = tid + 512 * i; const u32x4 v = *(const LAS u32x4*)(OUTB + (buf ^ 1) * 16384 + c * 16);
                *(u32x4*)(hout + (seqbase + (size_t)(sub - stp) * 64 + (c >> 4)) * hpitch + n * 128 + (c & 15) * 8) = v; }
        }
        {   LAS unsigned short* ob = (LAS unsigned short*)(OUTB + buf * 16384 + (kg * 4) * 256 + (w * 16 + l16) * 2);
#pragma unroll
            for (int mt = 0; mt < 4; ++mt)
#pragma unroll
                for (int rp = 0; rp < 2; ++rp) {
                    const float h0 = aX[mt][2 * rp] + aA[mt][2 * rp] * start[mt], h1 = aX[mt][2 * rp + 1] + aA[mt][2 * rp + 1] * start[mt];
                    const unsigned pk = cvt_pk_bf16(h0, h1);
                    ob[(mt * 16 + 2 * rp) * 128] = (unsigned short)(pk & 0xffffu); ob[(mt * 16 + 2 * rp + 1) * 128] = (unsigned short)(pk >> 16);
                }
        }
        RNN_BAR();
    }
    {
#pragma unroll
        for (int i = 0; i < 2; ++i) { const int c = tid + 512 * i; const u32x4 v = *(const LAS u32x4*)(OUTB + (127 & 1) * 16384 + c * 16);
            *(u32x4*)(hout + (seqbase + (size_t)(first + 127 * stp) * 64 + (c >> 4)) * hpitch + n * 128 + (c & 15) * 8) = v; }
    }
#undef RNN_LOADR
#undef RNN_PUT
#undef RNN_CONV
#undef RNN_BAR
}

__device__ __forceinline__ void phase_attn(LAS unsigned char* lds, bf16_t* proj, int layer, int nseq, unsigned* ctr) {
    LAS int* slot = (LAS int*)(lds + LDS_BYTES - 16);
    const int total = nseq * 256;
    const float* biasG = (const float*)(PWS() + OFF_BIAS);
    for (;;) {
        __syncthreads();
        if (TID() == 0) *slot = (int)atomicAdd(ctr, 1u);
        __syncthreads();
        const int idx = *slot;
        if (idx >= total) break;
        attn_unit(lds, proj, biasG, PIN(14) + layer * 8, idx >> 8, (idx >> 2) & 63, (idx >> 1) & 1, idx & 1);
    }
}
__device__ __forceinline__ void rnn_by_id(LAS unsigned char* lds, bf16_t* proj, int layer, int wk) {
    bf16_t* hb = (bf16_t*)(PWS() + OFF_HB);
    if (wk & 1) rnn_item<1>(lds, proj, hb, D, layer, wk >> 4, (wk >> 1) & 7); else rnn_item<0>(lds, proj, proj + C_YR, PW, layer, wk >> 4, (wk >> 1) & 7);
}
__global__ void __launch_bounds__(512) mega(Params p, int ph_lo, int ph_hi) {
    extern __shared__ __attribute__((aligned(16))) unsigned char lds_raw[];
    LAS unsigned char* lds = (LAS unsigned char*)lds_raw;
    if (TID() == 0) { volatile LAS unsigned* xst = (volatile LAS unsigned*)(lds + LDS_BYTES - 32); xst[0] = 0u; xst[1] = 0u; (void)xb_add(&((unsigned*)(PWS() + OFF_BAR))[XB_XCNT(xb_xcc_id())], 1u); }
    __syncthreads();
#ifdef PROBE_PASS_MASK
    constexpr int NPASS = 2;
#else
    constexpr int NPASS = 1;
#endif
    for (int pass = 0; pass < NPASS; ++pass)
    for (int ph = ph_lo; ph < ph_hi; ++ph) {
#ifdef PROBE_PASS_MASK
        if (pass == 0) { const int q_ = ph; const int bit_ = q_ == 0 ? 0 : (q_ == NPC - 1 ? 1 : 2 + (q_ - 1) % K_PER_LAYER); if (!((PROBE_PASS_MASK >> bit_) & 1)) continue; }
#endif
        unsigned char* const wsb = PWS();
        bf16_t* xb = (bf16_t*)(wsb + OFF_XB); bf16_t* proj = (bf16_t*)(wsb + OFF_PROJ); float* ssq = (float*)(wsb + OFF_SSQ);
        unsigned char* wb = wsb + OFF_W; unsigned* ctl = (unsigned*)(wsb + OFF_CTL) + (NPASS - 1 - pass) * 512;
        const int q = ph;
        constexpr int T = T_ALL;
        float* xo = POUT();
        bf16_t* hb = (bf16_t*)(wsb + OFF_HB);
        if (q == 0) { phase_pro(PIN(0), PIN(1) - (size_t)T_P * D, T); __syncthreads(); phase_wcvt(lds, 0); }
        else if (q == NPC - 1) { if (EN & 1) phase_fin(xo, T); }
        else {
            const int layer = (q - 1) / K_PER_LAYER, kind = (q - 1) % K_PER_LAYER;
            if (kind == K_WCVT && layer == 0) continue;
            if (kind == K_MIX1 && (int)gridDim.x >= N_RNN_ITEMS + 64) continue;
            if (kind == K_WCVT) { if (EN & 2) phase_wcvt(lds, layer); }
            else if (kind == K_UP1 || kind == K_UP2) {
                pg8::Gemm g{xb, (const bf16_t*)(wb + (kind == K_UP1 ? W_UP1 : W_UP2)), D, D, T, INW, D};
                pg8::EpiSwiGLU E{ssq, proj};
                pg8::gemm_phase(lds, g, E);
            } else if (kind == K_DN1 || kind == K_DN2 || kind == K_OUT) {
                pg8::Gemm g; pg8::EpiResid E;
                if (kind == K_OUT) { g = pg8::Gemm{hb, (const bf16_t*)(wb + W_OUT), D, D, T, D, D}; E = pg8::EpiResid{xo, xo, xo, xb, ssq, 1.0f}; }
                else { g = pg8::Gemm{proj, (const bf16_t*)(wb + (kind == K_DN1 ? W_DN1 : W_DN2)), DFF, DFF, T, D, DFF};
                       const bool l0 = (kind == K_DN1 && layer == 0); E = pg8::EpiResid{l0 ? PIN(0) : xo, l0 ? PIN(1) - (size_t)T_P * D : xo, xo, xb, ssq, 0.5f}; }
                pg8::gemm_phase(lds, g, E);
            } else if (kind == K_PROJA) {
                pg8::Gemm g{xb, (const bf16_t*)(wb + W_IN), D, D, T, 1024, D};
                pg8::EpiProj E{ssq, proj + C_XR, PW};
                pg8::gemm_phase(lds, g, E);
            } else if (kind == K_PROJ) {
                pg8::Gemm g{xb, (const bf16_t*)(wb + W_IN) + (size_t)1024 * D, D, D, T, 1536, D};
                pg8::EpiProj E{ssq, proj + 1024, PW};
                const int nb = (int)gridDim.x;
                if (nb >= N_RNN_ITEMS + 64) {
                    unsigned* sub = ctl + 256 + layer * 16;
                    if (BID() < N_RNN_ITEMS) { rnn_by_id(lds, proj, layer, BID()); sub_arrive_wait(sub, (unsigned)(nb - N_RNN_ITEMS), false); }
                    else { pg8::gemm_phase(lds, g, E, nb - N_RNN_ITEMS, BID() - N_RNN_ITEMS); sub_arrive_wait(sub, (unsigned)(nb - N_RNN_ITEMS), true); }
                    phase_attn(lds, proj, layer, NSEQ, ctl + layer * 16);
                } else {
                    pg8::gemm_phase(lds, g, E);
                    for (int wk = BID(); wk < N_RNN_ITEMS; wk += nb) { __syncthreads(); rnn_by_id(lds, proj, layer, wk); }
                }
            } else if (kind == K_MIX1) {
                phase_attn(lds, proj, layer, NSEQ, ctl + layer * 16);
            } else if (kind == K_MIX2) {
                pg8::Gemm g{xb, (const bf16_t*)(wb + W_IN) + (size_t)2560 * D, D, D, T, 2048, D};
                pg8::EpiYG E{ssq, proj, hb};
                pg8::gemm_phase(lds, g, E);
            } else if (kind == K_BRA) {
                { pg8::Gemm g{proj + C_Q, (const bf16_t*)(wb + W_BRA), PW, D, T, D, D};
                  pg8::EpiBranch<0> E{proj, hb};
                  pg8::gemm_phase(lds, g, E); }
                { pg8::Gemm g{xb, (const bf16_t*)(wb + W_IN) + (size_t)4608 * D, D, D, T, 1024, D};
                  pg8::EpiProj E{ssq, hb, D};
                  pg8::gemm_phase(lds, g, E); }
            } else {
                pg8::Gemm g{proj + C_YR, (const bf16_t*)(wb + W_BRR), PW, D, T, D, D};
                pg8::EpiBranch<1> E{proj, hb};
                pg8::gemm_phase(lds, g, E);
            }
        }
        if (ph + 1 < ph_hi || pass + 1 < NPASS) {
#ifdef USE_CG_SYNC
            if (true) cg::this_grid().sync();
#else
            if (ph == ph_lo && pass == 0) cg::this_grid().sync();
#endif
            else xcd_barrier((unsigned*)(PWS() + OFF_BAR), (volatile LAS unsigned*)(lds + LDS_BYTES - 32));
        }
#ifdef PROBE_SYNC3
        if (ph + 1 < ph_hi) { cg::this_grid().sync(); cg::this_grid().sync(); }
#endif
    }
}

extern "C" void kernel_launch(void* const* d_in, const int* in_sizes, int n_in, void* d_out, int out_size, void* d_ws, size_t ws_size, hipStream_t stream) {
    static int grid = 0;
    if (grid == 0) {
        if (n_in != 23 || ws_size < WS_NEED) { fprintf(stderr, "kernel_launch: need 23 inputs and %zu bytes of workspace (got %d, %zu)\n", (size_t)WS_NEED, n_in, ws_size); grid = -1; return; }
        int dev = 0, cus = 0, per_cu = 0;
        hipGetDevice(&dev);
        hipDeviceGetAttribute(&cus, hipDeviceAttributeMultiprocessorCount, dev);
        if (hipFuncSetAttribute((const void*)mega, hipFuncAttributeMaxDynamicSharedMemorySize, LDS_BYTES) != hipSuccess) { fprintf(stderr, "hipFuncSetAttribute failed\n"); grid = -1; return; }
        hipOccupancyMaxActiveBlocksPerMultiprocessor(&per_cu, (const void*)mega, 512, LDS_BYTES);
        if (per_cu < 1) { fprintf(stderr, "occupancy query says %d blocks/CU\n", per_cu); per_cu = 1; }
        (void)hipGetLastError();
        grid = cus * 1;
    }
    if (grid < 0) return;
    hipMemsetAsync((char*)d_ws + OFF_CTL, 0, 4096, stream);
    hipMemsetAsync((char*)d_ws + OFF_BAR, 0, 16384, stream);
    Params p{};
    for (int i = 0; i < 23; ++i) p.in[i] = (const float*)d_in[i];
    p.out = (float*)d_out; p.ws = (unsigned char*)d_ws;
#if PER_PHASE_LAUNCH
    for (int ph = 0; ph < NPH; ++ph) hipLaunchKernelGGL(mega, dim3(grid), dim3(512), LDS_BYTES, stream, p, ph, ph + 1);
#else
    int lo = 0, hi = NPH;
    void* args[] = {&p, &lo, &hi};
    hipError_t e = hipLaunchCooperativeKernel((const void*)mega, dim3(grid), dim3(512), args, LDS_BYTES, stream);
    if (e != hipSuccess) fprintf(stderr, "cooperative launch failed: %s (grid %d)\n", hipGetErrorString(e), grid);
#endif
}
```
